# Optimizing an MI355X kernel written in HIP

```python
import math
import jax, jax.numpy as jnp
from jax import lax
import numpy as np

D_MODEL = 1024
BATCH = 16
SEQ = 2048
DEPTH = 4
DEC_BATCH = 2
DEC_SEQ = 16384
PAST_LEN = 128

BRANCH_WIDTH = D_MODEL // 2
N_BRANCHES = 3
N_POOL_GROUPS = 4
POOL_GROUP_WIDTH = BRANCH_WIDTH // N_POOL_GROUPS
POOL_WINDOWS = (2, 4, 8, 16)
RWKV_HEAD = 64
RWKV_HEADS = BRANCH_WIDTH // RWKV_HEAD
W_LORA = 64
A_LORA = 64
G_LORA = 128
RWKV_GN_EPS = 64e-5
ATT_HEAD = 64
N_Q_HEADS = BRANCH_WIDTH // ATT_HEAD
N_KV_HEADS = 2
GQA_GROUP = N_Q_HEADS // N_KV_HEADS
WINDOW = 128
BLOCK = 128
N_BUCKETS = 32
MAX_DISTANCE = 128
NEG_INF = -1e30
D_FF = 4 * D_MODEL
LN_EPS = 1e-5
DEEPNORM_ALPHA = (2 * DEPTH) ** 0.25
DEEPNORM_BETA = (8 * DEPTH) ** -0.25

OFF_POOL = 0
OFF_RWKV = OFF_POOL + BRANCH_WIDTH
RWKV_IN = 3 * BRANCH_WIDTH + 2 * W_LORA + 2 * A_LORA + G_LORA
OFF_ATT = OFF_RWKV + RWKV_IN
ATT_IN = N_Q_HEADS * ATT_HEAD + 2 * N_KV_HEADS * ATT_HEAD
OFF_GATE = OFF_ATT + ATT_IN
N_IN = OFF_GATE + N_BRANCHES * D_MODEL

kernel_name = 'hybrid_bidir_pool_rwkv7_swa_encoder'


def _layer_norm(x, g, b):
    xf = x.astype(jnp.float32)
    mu = xf.mean(-1, keepdims=True)
    var = jnp.square(xf - mu).mean(-1, keepdims=True)
    return ((xf - mu) * lax.rsqrt(var + LN_EPS) * g + b).astype(x.dtype)


def _multiscale_pool(u):
    B, S, _ = u.shape
    ug = u.reshape(B, S, N_POOL_GROUPS, POOL_GROUP_WIDTH)
    c = jnp.concatenate([jnp.zeros_like(ug[:, :1]), jnp.cumsum(ug, axis=1)], axis=1)
    t = np.arange(S)
    outs = []
    for gi, w in enumerate(POOL_WINDOWS):
        lo = np.clip(t - w // 2, 0, S - 1)
        hi = np.clip(t + w // 2 - 1, 0, S - 1)
        cnt = (hi - lo + 1).astype(np.float32)
        cg = c[:, :, gi]
        win_sum = jnp.take(cg, hi + 1, axis=1) - jnp.take(cg, lo, axis=1)
        outs.append(win_sum / cnt[None, :, None])
    return jnp.stack(outs, axis=2) - ug


def _centred_shift(u, mu):
    zeros = jnp.zeros_like(u[:, :1])
    prev = jnp.concatenate([zeros, u[:, :-1]], axis=1)
    nxt = jnp.concatenate([u[:, 1:], zeros], axis=1)
    return u + mu * (0.5 * (prev + nxt) - u)


def _rwkv7_scan(r, w, k, v, a, b):
    def step(state, inp):
        rt, wt, kt, vt, at, bt = inp
        sa = jnp.einsum('...ij,...j->...i', state, at)
        state = state * wt[..., None, :] + sa[..., :, None] * bt[..., None, :] + vt[..., :, None] * kt[..., None, :]
        return state, jnp.einsum('...ij,...j->...i', state, rt)
    s0 = jnp.zeros(r.shape[1:] + (RWKV_HEAD,), jnp.float32)
    _, ys = lax.scan(step, s0, (r, w, k, v, a, b))
    return ys


def _rwkv7_bidir(zb, mu, w0, w2, a0, a2, g2, k_k, k_a, r_k, gn_g, gn_b):
    B, S, _ = zb.shape
    C = BRANCH_WIDTH
    zb = _centred_shift(zb, mu)
    r = zb[..., 0:C]
    k = zb[..., C:2 * C]
    v = zb[..., 2 * C:3 * C]
    o = 3 * C
    wlo = jnp.tanh(zb[..., o:o + 2 * W_LORA]).reshape(B, S, 2, W_LORA)
    o += 2 * W_LORA
    alo = zb[..., o:o + 2 * A_LORA].reshape(B, S, 2, A_LORA)
    o += 2 * A_LORA
    glo = zb[..., o:o + G_LORA]
    w = -jax.nn.softplus(-(w0 + jnp.einsum('bsdr,drc->bsdc', wlo, w2))) - 0.5
    decay = jnp.exp(-jnp.exp(w))
    a = jax.nn.sigmoid(a0 + jnp.einsum('bsdr,drc->bsdc', alo, a2))
    g = jax.nn.sigmoid(glo) @ g2
    kk = (k * k_k).reshape(B, S, RWKV_HEADS, RWKV_HEAD)
    kk = kk / jnp.maximum(jnp.sqrt(jnp.sum(kk * kk, -1, keepdims=True)), 1e-12)
    kk = kk.reshape(B, S, 1, C)
    kd = k[:, :, None, :] * (1.0 + (a - 1.0) * k_a)
    a_in = jnp.broadcast_to(-kk, (B, S, 2, C))
    b_in = kk * a
    r2 = jnp.broadcast_to(r[:, :, None, :], (B, S, 2, C))
    v2 = jnp.broadcast_to(v[:, :, None, :], (B, S, 2, C))

    def to_time(t):
        t = t.reshape(B, S, 2, RWKV_HEADS, RWKV_HEAD)
        t = jnp.stack([t[:, :, 0], t[:, ::-1, 1]], axis=2)
        return jnp.transpose(t, (1, 2, 0, 3, 4))

    ys = _rwkv7_scan(to_time(r2), to_time(decay), to_time(kd), to_time(v2), to_time(a_in), to_time(b_in))
    y = ys[:, 0] + ys[::-1, 1]
    y = jnp.transpose(y, (1, 0, 2, 3))
    ym = y.mean(-1, keepdims=True)
    yv = jnp.square(y - ym).mean(-1, keepdims=True)
    yn = ((y - ym) * lax.rsqrt(yv + RWKV_GN_EPS)).reshape(B, S, C) * gn_g + gn_b
    kbar = 0.5 * (kd[:, :, 0] + kd[:, :, 1])
    bonus = jnp.sum((r * kbar).reshape(B, S, RWKV_HEADS, RWKV_HEAD) * r_k, -1, keepdims=True) \
        * v.reshape(B, S, RWKV_HEADS, RWKV_HEAD)
    return (yn + bonus.reshape(B, S, C)) * g


def _t5_bucket(rel):
    half = N_BUCKETS // 2
    max_exact = half // 2
    n = np.abs(rel)
    large = max_exact + (np.log(np.maximum(n, 1) / max_exact) / math.log(MAX_DISTANCE / max_exact)
                         * (half - max_exact)).astype(np.int32)
    large = np.minimum(large, half - 1)
    return (rel > 0).astype(np.int32) * half + np.where(n < max_exact, n, large)


def _windowed_gqa(q, k, v, rel_bias, sink):
    B, S = q.shape[:2]
    nb = S // BLOCK
    qpos = np.arange(BLOCK)[:, None]
    koff = np.arange(3 * BLOCK)[None, :] - BLOCK
    rel = koff - qpos
    bias = rel_bias[_t5_bucket(rel)]
    bias = jnp.transpose(bias, (2, 0, 1)).reshape(N_KV_HEADS, GQA_GROUP, BLOCK, 3 * BLOCK)
    kpos = np.arange(nb)[:, None] * BLOCK + koff
    mask = (np.abs(rel) <= WINDOW)[None] & ((kpos >= 0) & (kpos < S))[:, None, :]

    def band(t):
        tp = jnp.pad(t, ((0, 0), (BLOCK, BLOCK), (0, 0), (0, 0)))
        tb = tp.reshape(B, nb + 2, BLOCK, N_KV_HEADS, ATT_HEAD)
        return jnp.concatenate([tb[:, :-2], tb[:, 1:-1], tb[:, 2:]], axis=2)

    kb, vb = band(k), band(v)
    qb = q.reshape(B, nb, BLOCK, N_KV_HEADS, GQA_GROUP, ATT_HEAD)
    s = jnp.einsum('bnqhgd,bnkhd->bnhgqk', qb, kb) * (ATT_HEAD ** -0.5) + bias
    s = jnp.where(mask[None, :, None, None], s, NEG_INF)
    sk = sink.astype(jnp.float32).reshape(N_KV_HEADS, GQA_GROUP)[:, :, None, None]
    m = jnp.maximum(s.max(-1, keepdims=True), sk)
    p = jnp.exp(s - m)
    p = p / (p.sum(-1, keepdims=True) + jnp.exp(sk - m))
    o = jnp.einsum('bnhgqk,bnkhd->bnqhgd', p, vb)
    return o.reshape(B, S, N_Q_HEADS * ATT_HEAD)


def _mixer(x, rel_bias, w_in, pool_w, pool_scale, mu, w0, w2, a0, a2, g2, k_k, k_a, r_k, gn_g, gn_b,
           sink, w_branch, w_o):
    B, S, _ = x.shape
    z = (x @ w_in).astype(jnp.float32)
    pa = _multiscale_pool(z[..., OFF_POOL:OFF_RWKV])
    a_out = jnp.einsum('bsgc,gcd->bsgd', pa, pool_w).reshape(B, S, BRANCH_WIDTH) * pool_scale
    b_out = _rwkv7_bidir(z[..., OFF_RWKV:OFF_ATT], mu, w0, w2, a0, a2, g2, k_k, k_a, r_k, gn_g, gn_b)
    zq = z[..., OFF_ATT:OFF_ATT + N_Q_HEADS * ATT_HEAD].reshape(B, S, N_Q_HEADS, ATT_HEAD)
    ok = OFF_ATT + N_Q_HEADS * ATT_HEAD
    zk = z[..., ok:ok + N_KV_HEADS * ATT_HEAD].reshape(B, S, N_KV_HEADS, ATT_HEAD)
    ov = ok + N_KV_HEADS * ATT_HEAD
    zv = z[..., ov:ov + N_KV_HEADS * ATT_HEAD].reshape(B, S, N_KV_HEADS, ATT_HEAD)
    c_out = _windowed_gqa(zq, zk, zv, rel_bias, sink)
    gates = jax.nn.sigmoid(z[..., OFF_GATE:].reshape(B, S, N_BRANCHES, D_MODEL))
    merged = gates[:, :, 0] * (a_out @ w_branch[0])
    merged = merged + gates[:, :, 1] * (b_out @ w_branch[1])
    merged = merged + gates[:, :, 2] * (c_out @ w_branch[2])
    return (merged @ w_o).astype(x.dtype)


def _trunk(x, rel_bias, w_in, pool_w, pool_scale, rwkv_mu, rwkv_w0, rwkv_w2, rwkv_a0, rwkv_a2, rwkv_g2,
           rwkv_k_k, rwkv_k_a, rwkv_r_k, rwkv_gn_g, rwkv_gn_b, attn_sink, w_branch, w_o,
           ln1_g, ln1_b, w_ff1, w_ff2, ln2_g, ln2_b):
    for l in range(DEPTH):
        h = _mixer(x, rel_bias, w_in[l], pool_w[l], pool_scale[l], rwkv_mu[l], rwkv_w0[l], rwkv_w2[l],
                   rwkv_a0[l], rwkv_a2[l], rwkv_g2[l], rwkv_k_k[l], rwkv_k_a[l], rwkv_r_k[l],
                   rwkv_gn_g[l], rwkv_gn_b[l], attn_sink[l], w_branch[l], w_o[l])
        x = _layer_norm(DEEPNORM_ALPHA * x + h, ln1_g[l], ln1_b[l])
        f = jnp.square(jax.nn.relu(x @ w_ff1[l])) @ w_ff2[l]
        x = _layer_norm(DEEPNORM_ALPHA * x + f, ln2_g[l], ln2_b[l])
    return x


def setup_inputs(seed: int = 0) -> dict:
    key = jax.random.key(seed)
    ks = jax.random.split(key, 32)
    f32 = jnp.float32
    nrm = lambda k, shape, s: jax.random.normal(k, shape, f32) * s
    L, D, C = DEPTH, D_MODEL, BRANCH_WIDTH
    beta = DEEPNORM_BETA
    return {
        'x_prompt': nrm(ks[0], (BATCH, SEQ, D), 1.0),
        'x_sample': nrm(ks[1], (DEC_BATCH, DEC_SEQ, D), 1.0),
        'rel_bias': nrm(ks[2], (N_BUCKETS, N_Q_HEADS), 0.5),
        'w_in': nrm(ks[3], (L, D, N_IN), D ** -0.5),
        'pool_w': nrm(ks[4], (L, N_POOL_GROUPS, POOL_GROUP_WIDTH, POOL_GROUP_WIDTH), POOL_GROUP_WIDTH ** -0.5),
        'pool_scale': 1.0 + nrm(ks[5], (L, C), 0.1),
        'rwkv_mu': jax.random.uniform(ks[6], (L, RWKV_IN), f32),
        'rwkv_w0': jax.random.uniform(ks[7], (L, 2, C), f32, -6.0, -1.0),
        'rwkv_w2': nrm(ks[8], (L, 2, W_LORA, C), 0.1 * W_LORA ** -0.5),
        'rwkv_a0': nrm(ks[9], (L, 2, C), 0.1),
        'rwkv_a2': nrm(ks[10], (L, 2, A_LORA, C), 0.1 * A_LORA ** -0.5),
        'rwkv_g2': nrm(ks[11], (L, G_LORA, C), G_LORA ** -0.5),
        'rwkv_k_k': 0.85 + nrm(ks[12], (L, C), 0.05),
        'rwkv_k_a': 1.0 + nrm(ks[13], (L, C), 0.05),
        'rwkv_r_k': nrm(ks[14], (L, RWKV_HEADS, RWKV_HEAD), 0.1),
        'rwkv_gn_g': 1.0 + nrm(ks[15], (L, C), 0.05),
        'rwkv_gn_b': nrm(ks[16], (L, C), 0.02),
        'attn_sink': nrm(ks[17], (L, N_Q_HEADS), 0.5),
        'w_branch': nrm(ks[18], (L, N_BRANCHES, C, D), beta * C ** -0.5),
        'w_o': nrm(ks[19], (L, D, D), beta * D ** -0.5),
        'ln1_g': 1.0 + nrm(ks[20], (L, D), 0.05),
        'ln1_b': nrm(ks[21], (L, D), 0.02),
        'w_ff1': nrm(ks[22], (L, D, D_FF), beta * D ** -0.5),
        'w_ff2': nrm(ks[23], (L, D_FF, D), beta * D_FF ** -0.5),
        'ln2_g': 1.0 + nrm(ks[24], (L, D), 0.05),
        'ln2_b': nrm(ks[25], (L, D), 0.02),
    }


def reference(x_prompt, x_sample, rel_bias, w_in, pool_w, pool_scale, rwkv_mu, rwkv_w0, rwkv_w2, rwkv_a0,
              rwkv_a2, rwkv_g2, rwkv_k_k, rwkv_k_a, rwkv_r_k, rwkv_gn_g, rwkv_gn_b, attn_sink, w_branch, w_o,
              ln1_g, ln1_b, w_ff1, w_ff2, ln2_g, ln2_b):
    y_prompt = _trunk(x_prompt, rel_bias, w_in, pool_w, pool_scale, rwkv_mu, rwkv_w0, rwkv_w2, rwkv_a0,
                      rwkv_a2, rwkv_g2, rwkv_k_k, rwkv_k_a, rwkv_r_k, rwkv_gn_g, rwkv_gn_b, attn_sink,
                      w_branch, w_o, ln1_g, ln1_b, w_ff1, w_ff2, ln2_g, ln2_b)
    y_sample = _trunk(x_sample, rel_bias, w_in, pool_w, pool_scale, rwkv_mu, rwkv_w0, rwkv_w2, rwkv_a0,
                      rwkv_a2, rwkv_g2, rwkv_k_k, rwkv_k_a, rwkv_r_k, rwkv_gn_g, rwkv_gn_b, attn_sink,
                      w_branch, w_o, ln1_g, ln1_b, w_ff1, w_ff2, ln2_g, ln2_b)
    return (y_prompt, y_sample)
```

```cpp
#include <hip/hip_runtime.h>
#include <hip/hip_fp16.h>
#include <hip/hip_cooperative_groups.h>
#include <cstdio>
#include <cstdint>
namespace cg = cooperative_groups;

typedef _Float16 h16;
typedef _Float16 half8 __attribute__((ext_vector_type(8)));
typedef _Float16 half4 __attribute__((ext_vector_type(4)));
typedef float floatx16 __attribute__((ext_vector_type(16)));
typedef float floatx4 __attribute__((ext_vector_type(4)));
typedef float float2v __attribute__((ext_vector_type(2)));
typedef unsigned int u32x4 __attribute__((ext_vector_type(4)));
typedef const __attribute__((address_space(4))) float2v* cf2p;

#define DI __device__ __forceinline__
#ifdef ONLY
#define PH(n) (ONLY == (n))
#else
#define PH(n) true
#endif

struct Params {
  const float* in[26];
  float* out;
  char* ws;
};

constexpr int NTOK = 65536;
constexpr size_t MiB = 1ull << 20;
constexpr size_t D_X16 = 0, D_BOUT = 128 * MiB, D_LORA = 192 * MiB, D_G16 = 240 * MiB;
constexpr size_t W_WT = 0;
constexpr size_t W_SB = 36 * MiB, W_PE = 324 * MiB, W_YBUF = 388 * MiB, W_ZPASS = 452 * MiB;
constexpr size_t W_ZPA = 36 * MiB, W_PA = 100 * MiB, W_AOUT = 260 * MiB, W_COUT = 324 * MiB, W_ZATT = 212 * MiB;
constexpr size_t W_MERGED = 36 * MiB, W_YPRE1 = 164 * MiB;
constexpr size_t W_HID = 36 * MiB, W_YPRE2 = 292 * MiB;
constexpr size_t W_BAR = 504 * MiB;
constexpr size_t WT_IN = 0, WT_BR = 6422528, WT_O = 7995392, WT_F1 = 9043968, WT_F2 = 13238272,
                 WT_POOL = 17432576, WT_W2 = 17498112, WT_A2 = 17563648, WT_G2 = 17629184;

constexpr float ALPHA = 1.681792830507429f;

DI void seq_of(int tok, int& s0, int& len) {
  if (tok < 32768) { s0 = tok & ~2047; len = 2048; }
  else { s0 = 32768 + ((tok - 32768) & ~16383); len = 16384; }
}
DI int otid() { int t = threadIdx.x; asm volatile("" : "+v"(t)); return t; }
template <int CTRL> DI float dppf(float v) {
  return __builtin_bit_cast(float, __builtin_amdgcn_mov_dpp(__builtin_bit_cast(int, v), CTRL, 0xf, 0xf, true));
}
DI float wave_sum(float v) {
  v += dppf<0xB1>(v);
  v += dppf<0x4E>(v);
  v += dppf<0x141>(v);
  v += dppf<0x140>(v);
  v += __builtin_bit_cast(float, __builtin_amdgcn_ds_swizzle(__builtin_bit_cast(int, v), 0x401F));
  const float a = __builtin_bit_cast(float, __builtin_amdgcn_readlane(__builtin_bit_cast(int, v), 0));
  const float b = __builtin_bit_cast(float, __builtin_amdgcn_readlane(__builtin_bit_cast(int, v), 32));
  return a + b;
}
DI float sigmoidf_(float x) { return __builtin_amdgcn_rcpf(1.f + __expf(-x)); }
DI float2v fma2(float2v a, float2v b, float2v c) { return __builtin_elementwise_fma(a, b, c); }

DI void tconv(const float* __restrict__ src, h16* __restrict__ dst, int K, int N, float* tile) {
  const int tn = N >> 6, tk = K >> 6, t = otid();
  for (int job = blockIdx.x; job < tk * tn; job += gridDim.x) {
    const int k0 = (job / tn) << 6, n0 = (job % tn) << 6;
    __syncthreads();
#pragma unroll
    for (int i = 0; i < 4; ++i) {
      const int k = (t >> 4) + 16 * i, n4 = (t & 15) * 4;
      const float4 v = *(const float4*)&src[(size_t)(k0 + k) * N + n0 + n4];
      tile[k * 65 + n4 + 0] = v.x; tile[k * 65 + n4 + 1] = v.y;
      tile[k * 65 + n4 + 2] = v.z; tile[k * 65 + n4 + 3] = v.w;
    }
    __syncthreads();
    const int n = t >> 2, ks = (t & 3) * 16;
    half8 o0, o1;
#pragma unroll
    for (int j = 0; j < 8; ++j) {
      o0[j] = (h16)tile[(ks + j) * 65 + n];
      o1[j] = (h16)tile[(ks + 8 + j) * 65 + n];
    }
    *(half8*)&dst[(size_t)(n0 + n) * K + k0 + ks] = o0;
    *(half8*)&dst[(size_t)(n0 + n) * K + k0 + ks + 8] = o1;
  }
}

template <int NJ>
DI void gemm_core(const h16* __restrict__ A, int lda, const h16* __restrict__ Bt, int ldb, int K,
                  floatx16 (&acc)[2][NJ], h16* As, h16* Bs) {
  const int t = otid(), l = t & 63, w = t >> 6, wm = w >> 1, wn = w & 1, h = l >> 5, lr = l & 31;
  u32x4 ra0[4], rb0[2 * NJ], ra1[4], rb1[2 * NJ];
  const h16* Ap = A + (size_t)(t >> 3) * lda + (t & 7) * 8;
  const h16* Bp = Bt + (size_t)(t >> 3) * ldb + (t & 7) * 8;
  const size_t sa = (size_t)32 * lda, sbb = (size_t)32 * ldb;
#define G_LOAD(RA, RB, k_) do { \
    _Pragma("unroll") for (int i = 0; i < 4; ++i) RA[i] = *(const u32x4*)&Ap[i * sa + (k_)]; \
    _Pragma("unroll") for (int i = 0; i < 2 * NJ; ++i) RB[i] = *(const u32x4*)&Bp[i * sbb + (k_)]; } while (0)
#define G_STEP(RA, RB, kn_) do { \
    __syncthreads(); \
    _Pragma("unroll") for (int i = 0; i < 4; ++i) *(u32x4*)&As[((t >> 3) + 32 * i) * 72 + (t & 7) * 8] = RA[i]; \
    _Pragma("unroll") for (int i = 0; i < 2 * NJ; ++i) *(u32x4*)&Bs[((t >> 3) + 32 * i) * 72 + (t & 7) * 8] = RB[i]; \
    __syncthreads(); \
    if ((kn_) < K) G_LOAD(RA, RB, kn_); \
    { half8 a[2][2], b[2][NJ]; \
      _Pragma("unroll") for (int i = 0; i < 2; ++i) a[0][i] = *(const half8*)&As[(wm * 64 + i * 32 + lr) * 72 + h * 8]; \
      _Pragma("unroll") for (int j = 0; j < NJ; ++j) b[0][j] = *(const half8*)&Bs[(wn * 32 * NJ + j * 32 + lr) * 72 + h * 8]; \
      _Pragma("unroll") for (int s = 0; s < 4; ++s) { \
        if (s < 3) { \
          _Pragma("unroll") for (int i = 0; i < 2; ++i) a[(s + 1) & 1][i] = *(const half8*)&As[(wm * 64 + i * 32 + lr) * 72 + (s + 1) * 16 + h * 8]; \
          _Pragma("unroll") for (int j = 0; j < NJ; ++j) b[(s + 1) & 1][j] = *(const half8*)&Bs[(wn * 32 * NJ + j * 32 + lr) * 72 + (s + 1) * 16 + h * 8]; \
        } \
        __builtin_amdgcn_sched_barrier(0); \
        _Pragma("unroll") for (int i = 0; i < 2; ++i) \
          _Pragma("unroll") for (int j = 0; j < NJ; ++j) \
            acc[i][j] = __builtin_amdgcn_mfma_f32_32x32x16_f16(a[s & 1][i], b[s & 1][j], acc[i][j], 0, 0, 0); \
        __builtin_amdgcn_sched_barrier(0); \
      } } } while (0)
  G_LOAD(ra0, rb0, 0);
  if (64 < K) G_LOAD(ra1, rb1, 64);
  for (int k0 = 0; k0 < K; k0 += 128) {
    G_STEP(ra0, rb0, k0 + 128);
    if (k0 + 64 < K) G_STEP(ra1, rb1, k0 + 192);
  }
#undef G_LOAD
#undef G_STEP
}
template <int NJ>
DI void acc_zero(floatx16 (&acc)[2][NJ]) {
#pragma unroll
  for (int i = 0; i < 2; ++i)
#pragma unroll
    for (int j = 0; j < NJ; ++j)
#pragma unroll
      for (int r = 0; r < 16; ++r) acc[i][j][r] = 0.f;
}
template <int NJ, class F>
DI void epi_apply(const floatx16 (&acc)[2][NJ], F f) {
  const int t = otid(), l = t & 63, w = t >> 6, wm = w >> 1, wn = w & 1, h = l >> 5, lr = l & 31;
#pragma unroll
  for (int i = 0; i < 2; ++i)
#pragma unroll
    for (int j = 0; j < NJ; ++j)
#pragma unroll
      for (int r = 0; r < 16; ++r) {
        f(wm * 64 + i * 32 + (r & 3) + 8 * (r >> 2) + 4 * h, wn * 32 * NJ + j * 32 + lr, acc[i][j][r]);
        if ((r & 3) == 3) __builtin_amdgcn_sched_barrier(0);
      }
}

DI void attn_item(int item, const h16* __restrict__ zpa, h16* __restrict__ cout, const float* __restrict__ rel_bias,
                  const float* __restrict__ sink_l, h16* Ks, h16* Vt, float* bt) {
  const int t = otid(), l = t & 63, w = t >> 6, h = l >> 5, lr = l & 31;
  const int hq = item & 7, qb = item >> 3;
  const int tok0 = qb * 128;
  int s0, len; seq_of(tok0, s0, len);
  const int nb = (tok0 - s0) >> 7, nblk = len >> 7;
  const int kvh = hq >> 2;
  __syncthreads();
  for (int r = t; r < 257; r += 256) {
    const int rel = r - 128;
    const int n = rel < 0 ? -rel : rel;
    int bk = n < 8 ? n : 8 + (n >= 12) + (n >= 16) + (n >= 23) + (n >= 32) + (n >= 46) + (n >= 64) + (n >= 91);
    if (rel > 0) bk += 16;
    bt[r] = rel_bias[bk * 8 + hq];
  }
  const int ql = w * 32 + lr;
  const int qtok = tok0 + ql;
  half8 qf[4];
#pragma unroll
  for (int ds = 0; ds < 4; ++ds) qf[ds] = *(const half8*)&zpa[(size_t)qtok * 768 + hq * 64 + ds * 16 + h * 8];
  float m = sink_l[hq], lsum = 1.f;
  floatx16 O[2];
#pragma unroll
  for (int dt = 0; dt < 2; ++dt)
#pragma unroll
    for (int r = 0; r < 16; ++r) O[dt][r] = 0.f;
  for (int kb = 0; kb < 3; ++kb) {
    const int kblk = nb - 1 + kb;
    if (kblk < 0 || kblk >= nblk) continue;
    const int ktok0 = s0 + kblk * 128;
    __syncthreads();
#pragma unroll
    for (int i = 0; i < 4; ++i) {
      const int c = t + 256 * i, key = c >> 3, seg = c & 7;
      const u32x4 kv = *(const u32x4*)&zpa[(size_t)(ktok0 + key) * 768 + 512 + kvh * 64 + seg * 8];
      *(u32x4*)&Ks[key * 72 + seg * 8] = kv;
      const half8 vv = *(const half8*)&zpa[(size_t)(ktok0 + key) * 768 + 640 + kvh * 64 + seg * 8];
      const int kl = key & 31;
      const int pos = (key & ~31) + (kl & 16) + ((kl >> 2) & 1) * 8 + ((kl >> 3) & 1) * 4 + (kl & 3);
#pragma unroll
      for (int e = 0; e < 8; ++e) Vt[(seg * 8 + e) * 136 + pos] = vv[e];
    }
    __syncthreads();
    floatx16 sc[4];
#pragma unroll
    for (int kt = 0; kt < 4; ++kt) {
#pragma unroll
      for (int r = 0; r < 16; ++r) sc[kt][r] = 0.f;
#pragma unroll
      for (int ds = 0; ds < 4; ++ds) {
        const half8 kf = *(const half8*)&Ks[(kt * 32 + lr) * 72 + ds * 16 + h * 8];
        sc[kt] = __builtin_amdgcn_mfma_f32_32x32x16_f16(kf, qf[ds], sc[kt], 0, 0, 0);
      }
    }
    float bmax = -1e30f;
#pragma unroll
    for (int kt = 0; kt < 4; ++kt)
#pragma unroll
      for (int r = 0; r < 16; ++r) {
        const int keyl = kt * 32 + (r & 3) + 8 * (r >> 2) + 4 * h;
        const int rel = (kb - 1) * 128 + keyl - ql;
        const bool ok = (rel >= -128) && (rel <= 128);
        const int ri = ok ? rel + 128 : 128;
        const float sv = ok ? sc[kt][r] * 0.125f + bt[ri] : -1e30f;
        sc[kt][r] = sv;
        bmax = fmaxf(bmax, sv);
      }
    bmax = fmaxf(bmax, __shfl_xor(bmax, 32));
    const float mnew = fmaxf(m, bmax);
    const float scale = __expf(m - mnew);
    float psum = 0.f;
#pragma unroll
    for (int kt = 0; kt < 4; ++kt)
#pragma unroll
      for (int r = 0; r < 16; ++r) {
        const float pv = __expf(sc[kt][r] - mnew);
        sc[kt][r] = pv;
        psum += pv;
      }
    psum += __shfl_xor(psum, 32);
    lsum = lsum * scale + psum;
    m = mnew;
#pragma unroll
    for (int dt = 0; dt < 2; ++dt)
#pragma unroll
      for (int r = 0; r < 16; ++r) O[dt][r] *= scale;
#pragma unroll
    for (int kt = 0; kt < 4; ++kt)
#pragma unroll
      for (int s = 0; s < 2; ++s) {
        half8 pf;
#pragma unroll
        for (int j = 0; j < 8; ++j) pf[j] = (h16)sc[kt][8 * s + j];
#pragma unroll
        for (int dt = 0; dt < 2; ++dt) {
          const half8 vf = *(const half8*)&Vt[(dt * 32 + lr) * 136 + kt * 32 + s * 16 + h * 8];
          O[dt] = __builtin_amdgcn_mfma_f32_32x32x16_f16(vf, pf, O[dt], 0, 0, 0);
        }
      }
  }
  const float inv = 1.f / lsum;
#pragma unroll
  for (int dt = 0; dt < 2; ++dt)
#pragma unroll
    for (int g = 0; g < 4; ++g) {
      half4 o;
#pragma unroll
      for (int e = 0; e < 4; ++e) o[e] = (h16)(O[dt][4 * g + e] * inv);
      *(half4*)&cout[(size_t)qtok * 512 + hq * 64 + dt * 32 + 8 * g + 4 * h] = o;
    }
}

template <int N> DI void fmac_bc(float& acc, float vec, float s) {
  asm("v_fmac_f32_dpp %0, %1, %2 row_newbcast:%3 row_mask:0xf bank_mask:0xf" : "+v"(acc) : "v"(vec), "v"(s), "i"(N));
}
template <int N> DI float mul_bc(float vec, float s) {
  float r;
  asm("v_mul_f32_dpp %0, %1, %2 row_newbcast:%3 row_mask:0xf bank_mask:0xf" : "=v"(r) : "v"(vec), "v"(s), "i"(N));
  return r;
}
struct ScanIn { floatx4 kk, w, nb, kd, r; float vi; };
struct ScanRaw { half4 kk, nb, kd, r; floatx4 w; h16 vi; };
DI floatx4 h4f(half4 v) { return floatx4{(float)v[0], (float)v[1], (float)v[2], (float)v[3]}; }
DI void pin4(floatx4& v) {
  float a = v[0], b = v[1], c = v[2], d = v[3];
  asm volatile("" : "+v"(a), "+v"(b), "+v"(c), "+v"(d));
  v = floatx4{a, b, c, d};
}
template <int MODE>
DI ScanRaw scan_ld(const float* __restrict__ sb, int c, int hh, int d, int s, unsigned o, unsigned lane) {
  const int tok = c * 128 + (d ? 127 - s : s);
  const float* p = sb + ((size_t)tok * 2 + hh) * 352;
  const h16* ph = (const h16*)(p + 128);
  const h16* pdh = ph + d * 128;
  ScanRaw in;
  in.kk = *(const half4*)&ph[o];
  in.w = *(const floatx4*)&p[d * 64 + o];
  in.nb = *(const half4*)&pdh[192 + o];
  if (MODE != 1) { in.kd = *(const half4*)&pdh[256 + o]; in.vi = ph[128 + lane]; }
  if (MODE == 2) in.r = *(const half4*)&ph[64 + o];
  return in;
}
#define SCAN_R4(M, b) M(b) M(b + 1) M(b + 2) M(b + 3)
#define SCAN_R16(M, b) SCAN_R4(M, b) SCAN_R4(M, b + 4) SCAN_R4(M, b + 8) SCAN_R4(M, b + 12)
#define SCAN_R64(M) SCAN_R16(M, 0) SCAN_R16(M, 16) SCAN_R16(M, 32) SCAN_R16(M, 48)
template <int MODE>
DI float scan_step(float (&S)[64], const ScanRaw& raw) {
  ScanIn in;
  in.kk = h4f(raw.kk); in.w = raw.w; in.nb = h4f(raw.nb);
  if (MODE != 1) { in.kd = h4f(raw.kd); in.vi = (float)raw.vi; }
  if (MODE == 2) in.r = h4f(raw.r);
  pin4(in.kk); pin4(in.w); pin4(in.nb);
  if (MODE != 1) { pin4(in.kd); asm volatile("" : "+v"(in.vi)); }
  if (MODE == 2) pin4(in.r);
  __builtin_amdgcn_sched_barrier(0);
  asm volatile("s_nop 4");
  float dd[8], yy[8];
#pragma unroll
  for (int k = 0; k < 8; ++k) { dd[k] = 0.f; yy[k] = 0.f; }
#define SC_DOT(j) fmac_bc<((j) >> 2)>(dd[(j) & 7], in.kk[(j) & 3], S[j]);
  SCAN_R64(SC_DOT)
  const float dot = ((dd[0] + dd[1]) + (dd[2] + dd[3])) + ((dd[4] + dd[5]) + (dd[6] + dd[7]));
#define SC_U1(b, k) t_[k] = mul_bc<(((b) + (k)) >> 2)>(in.nb[((b) + (k)) & 3], dot);
#define SC_U2(b, k) if (MODE != 1) fmac_bc<(((b) + (k)) >> 2)>(t_[k], in.kd[((b) + (k)) & 3], in.vi);
#define SC_U3(b, k) fmac_bc<(((b) + (k)) >> 2)>(t_[k], in.w[((b) + (k)) & 3], S[(b) + (k)]); S[(b) + (k)] = t_[k];
#define SC_U4(b, k) if (MODE == 2) fmac_bc<(((b) + (k)) >> 2)>(yy[k], in.r[((b) + (k)) & 3], t_[k]);
#define SC_A8(M, b) M(b, 0) M(b, 1) M(b, 2) M(b, 3) M(b, 4) M(b, 5) M(b, 6) M(b, 7)
#define SC_G(b) { float t_[8]; SC_A8(SC_U1, b) SC_A8(SC_U2, b) SC_A8(SC_U3, b) SC_A8(SC_U4, b) }
  SC_G(0) SC_G(8) SC_G(16) SC_G(24) SC_G(32) SC_G(40) SC_G(48) SC_G(56)
  __builtin_amdgcn_sched_barrier(0);
  return ((yy[0] + yy[1]) + (yy[2] + yy[3])) + ((yy[4] + yy[5]) + (yy[6] + yy[7]));
}
template <int MODE>
DI void scan_item(const float* __restrict__ sb, float* __restrict__ pe, float* __restrict__ ybuf, int item, int lane) {
  const int c = item >> 2, hh = (item >> 1) & 1, d = item & 1;
  float S[64];
  float* pbase = pe + (size_t)item * 8192;
  if (MODE == 2) {
#pragma unroll
    for (int j = 0; j < 16; ++j) {
      const floatx4 v = *(const floatx4*)&pbase[4096 + lane * 64 + 4 * j];
      S[4 * j] = v[0]; S[4 * j + 1] = v[1]; S[4 * j + 2] = v[2]; S[4 * j + 3] = v[3];
    }
  } else {
#pragma unroll
    for (int j = 0; j < 64; ++j) S[j] = (MODE == 1 && j == lane) ? 1.f : 0.f;
  }
  float* yout = ybuf + (size_t)d * NTOK * 128 + hh * 64 + lane;
  const unsigned o = 4u * (lane & 15), ul = lane;
  ScanRaw r0 = scan_ld<MODE>(sb, c, hh, d, 0, o, ul), r1 = scan_ld<MODE>(sb, c, hh, d, 1, o, ul), r2 = scan_ld<MODE>(sb, c, hh, d, 2, o, ul);
  for (int s = 0; s < 128; s += 4) {
    ScanRaw r3 = scan_ld<MODE>(sb, c, hh, d, s + 3, o, ul);
    float y = scan_step<MODE>(S, r0);
    if (MODE == 2) yout[(size_t)(c * 128 + (d ? 127 - s : s)) * 128] = y;
    r0 = scan_ld<MODE>(sb, c, hh, d, min(s + 4, 127), o, ul);
    y = scan_step<MODE>(S, r1);
    if (MODE == 2) yout[(size_t)(c * 128 + (d ? 126 - s : s + 1)) * 128] = y;
    r1 = scan_ld<MODE>(sb, c, hh, d, min(s + 5, 127), o, ul);
    y = scan_step<MODE>(S, r2);
    if (MODE == 2) yout[(size_t)(c * 128 + (d ? 125 - s : s + 2)) * 128] = y;
    r2 = scan_ld<MODE>(sb, c, hh, d, min(s + 6, 127), o, ul);
    y = scan_step<MODE>(S, r3);
    if (MODE == 2) yout[(size_t)(c * 128 + (d ? 124 - s : s + 3)) * 128] = y;
  }
  if (MODE == 0) {
    float* o = pbase + 4096 + lane * 64;
#pragma unroll
    for (int j = 0; j < 16; ++j) *(floatx4*)&o[4 * j] = floatx4{S[4 * j], S[4 * j + 1], S[4 * j + 2], S[4 * j + 3]};
  }
  if (MODE == 1) {
    h16* pf = (h16*)pbase + (((lane >> 5) * 64 + ((lane >> 2) & 3) * 16) * 8 + 4 * ((lane >> 4) & 1) + (lane & 3));
#pragma unroll
    for (int j = 0; j < 64; ++j) pf[(j >> 4) * 1024 + (j & 15) * 8] = (h16)S[j];
  }
}
template <bool L3>
DI void scan_l13(const float* __restrict__ sb, float* __restrict__ pe, float* __restrict__ ybuf, int gw, int nw) {
  const int lane = otid() & 63;
  if (L3) {
    for (int item = gw; item < 2048; item += nw) scan_item<2>(sb, pe, ybuf, item, lane);
  } else {
    for (int it = gw; it < 2048; it += nw) scan_item<0>(sb, pe, ybuf, it, lane);
    for (int it = gw; it < 2048; it += nw) scan_item<1>(sb, pe, ybuf, it, lane);
  }
}

DI void scan_l2(float* __restrict__ pe, char* lds) {
  const int t = otid(), l = t & 63, rg = t >> 6, g = l >> 4, lc = l & 15;
  for (int ch = blockIdx.x; ch < 72; ch += gridDim.x) {
    const int seq = ch >> 2, hh = (ch >> 1) & 1, d = ch & 1;
    const int c0 = seq < 16 ? seq * 16 : 256 + (seq - 16) * 128;
    const int n = seq < 16 ? 16 : 128;
    const int i = rg * 16 + lc;
    floatx4 S[4];
#pragma unroll
    for (int mt = 0; mt < 4; ++mt) S[mt] = floatx4{0.f, 0.f, 0.f, 0.f};
    u32x4 pr[4][2]; floatx4 er[4][4];
#define L2_LOAD(k_, u_) do { const int c_ = d ? c0 + n - 1 - (k_) : c0 + (k_); \
      const float* b_ = pe + (size_t)(c_ * 4 + hh * 2 + d) * 8192; \
      pr[u_][0] = *(const u32x4*)((const char*)b_ + t * 16); pr[u_][1] = *(const u32x4*)((const char*)b_ + 4096 + t * 16); \
      _Pragma("unroll") for (int mt = 0; mt < 4; ++mt) er[u_][mt] = *(const floatx4*)&b_[4096 + i * 64 + 16 * mt + 4 * g]; } while (0)
    L2_LOAD(0, 0); L2_LOAD(1, 1); L2_LOAD(2, 2); L2_LOAD(3, 3);
    for (int k = 0; k < n; k += 4) {
#pragma unroll
      for (int u = 0; u < 4; ++u) {
        const int kk = k + u;
        char* slot = lds + (u & 1) * 8192;
        *(u32x4*)(slot + t * 16) = pr[u][0];
        *(u32x4*)(slot + 4096 + t * 16) = pr[u][1];
        floatx4 E[4];
#pragma unroll
        for (int mt = 0; mt < 4; ++mt) E[mt] = er[u][mt];
        if (kk + 4 < n) L2_LOAD(kk + 4, u);
        __syncthreads();
        const int c = d ? c0 + n - 1 - kk : c0 + kk;
        float* Em = pe + (size_t)(c * 4 + hh * 2 + d) * 8192 + 4096;
        half8 bf[2];
#pragma unroll
        for (int kb = 0; kb < 2; ++kb)
#pragma unroll
          for (int e = 0; e < 8; ++e) bf[kb][e] = (h16)S[2 * kb + (e >> 2)][e & 3];
#pragma unroll
        for (int mt = 0; mt < 4; ++mt) *(floatx4*)&Em[i * 64 + 16 * mt + 4 * g] = S[mt];
        half8 af[4][2];
#pragma unroll
        for (int mt = 0; mt < 4; ++mt)
#pragma unroll
          for (int kb = 0; kb < 2; ++kb) af[mt][kb] = *(const half8*)(slot + ((mt * 2 + kb) * 64 + l) * 16);
        __builtin_amdgcn_sched_barrier(0);
#pragma unroll
        for (int mt = 0; mt < 4; ++mt) E[mt] = __builtin_amdgcn_mfma_f32_16x16x32_f16(af[mt][0], bf[0], E[mt], 0, 0, 0);
#pragma unroll
        for (int mt = 0; mt < 4; ++mt) S[mt] = __builtin_amdgcn_mfma_f32_16x16x32_f16(af[mt][1], bf[1], E[mt], 0, 0, 0);
      }
    }
    __syncthreads();
  }
}

DI void ln_phase(const h16* __restrict__ y, const float* __restrict__ gam, const float* __restrict__ bet,
                 h16* __restrict__ x16, float* __restrict__ outf, bool final_, int gw, int nw) {
  const int lane = otid() & 63;
  for (int tok = gw; tok < NTOK; tok += nw) {
    const half8 a = *(const half8*)&y[(size_t)tok * 1024 + lane * 8];
    const half8 b = *(const half8*)&y[(size_t)tok * 1024 + 512 + lane * 8];
    float v[16];
    float s = 0.f;
#pragma unroll
    for (int j = 0; j < 8; ++j) { v[j] = (float)a[j]; v[8 + j] = (float)b[j]; s += v[j] + v[8 + j]; }
    const float mu = wave_sum(s) * (1.f / 1024.f);
    float q = 0.f;
#pragma unroll
    for (int j = 0; j < 16; ++j) { const float dd = v[j] - mu; q += dd * dd; }
    const float rstd = rsqrtf(wave_sum(q) * (1.f / 1024.f) + 1e-5f);
    float o[16];
#pragma unroll
    for (int j = 0; j < 8; ++j) {
      o[j] = (v[j] - mu) * rstd * gam[lane * 8 + j] + bet[lane * 8 + j];
      o[8 + j] = (v[8 + j] - mu) * rstd * gam[512 + lane * 8 + j] + bet[512 + lane * 8 + j];
    }
    if (final_) {
      float* op = outf + (size_t)tok * 1024;
      *(float4*)&op[lane * 8] = float4{o[0], o[1], o[2], o[3]};
      *(float4*)&op[lane * 8 + 4] = float4{o[4], o[5], o[6], o[7]};
      *(float4*)&op[512 + lane * 8] = float4{o[8], o[9], o[10], o[11]};
      *(float4*)&op[512 + lane * 8 + 4] = float4{o[12], o[13], o[14], o[15]};
    } else {
      half8 oa, ob;
#pragma unroll
      for (int j = 0; j < 8; ++j) { oa[j] = (h16)o[j]; ob[j] = (h16)o[8 + j]; }
      *(half8*)&x16[(size_t)tok * 1024 + lane * 8] = oa;
      *(half8*)&x16[(size_t)tok * 1024 + 512 + lane * 8] = ob;
    }
  }
}

#define XB_TMO      128
#define XB_XCNT(j)  (256  + 64 * (j))
#define XB_XSUB(j)  (1280 + 64 * (j))
#define XB_XGEN(j)  (2304 + 64 * (j))
#define XB_TOP      3328
#define XB_TOPGEN   3392
#define XCD_BAR_WORDS 3456
#define XB_SPIN_CAP (1u << 18)
#define LAS __attribute__((address_space(3)))
DI unsigned xb_ld(unsigned* p) { return __hip_atomic_load(p, __ATOMIC_RELAXED, __HIP_MEMORY_SCOPE_AGENT); }
DI unsigned xb_add(unsigned* p, unsigned v) { return __hip_atomic_fetch_add(p, v, __ATOMIC_RELAXED, __HIP_MEMORY_SCOPE_AGENT); }
DI unsigned xb_xcc_id() { return (unsigned)__builtin_amdgcn_s_getreg((3 << 11) | 20) & 0xFu; }
#define XB_SPIN(cond, bar) do { unsigned _sp = 0; while (cond) { __builtin_amdgcn_s_sleep(1); \
    if ((++_sp & 255u) == 0u) { if (xb_ld(&(bar)[XB_TMO])) break; if (_sp > XB_SPIN_CAP) { atomicAdd(&(bar)[XB_TMO], 1u); break; } } } } while (0)
struct XcdBarrier { unsigned* bar; unsigned x; volatile LAS unsigned* st; };
DI XcdBarrier xcd_barrier_post(unsigned* bar, volatile LAS unsigned* st) {
  XcdBarrier b; b.bar = bar; b.x = xb_xcc_id(); b.st = st;
  if (threadIdx.x == 0) (void)xb_add(&bar[XB_XCNT(b.x)], 1u);
  return b;
}
DI void xcd_barrier_complete(unsigned* bar, unsigned x, unsigned& nloc, unsigned& nx) {
  const unsigned G = gridDim.x * gridDim.y * gridDim.z;
  unsigned sum, cnt, mine, sp = 0u;
  for (;;) {
    sum = 0u; cnt = 0u; mine = 0u;
#pragma unroll
    for (unsigned j = 0; j < 16; ++j) { const unsigned c = xb_ld(&bar[XB_XCNT(j)]); sum += c; cnt += (c > 0u) ? 1u : 0u; mine = (j == x) ? c : mine; }
    if (sum == G) break;
    __builtin_amdgcn_s_sleep(1);
    if ((++sp & 255u) == 0u) { if (xb_ld(&bar[XB_TMO])) break; if (sp > XB_SPIN_CAP) { atomicAdd(&bar[XB_TMO], 1u); break; } }
  }
  nloc = mine > 0u ? mine : 1u; nx = cnt > 0u ? cnt : 1u;
}
DI void xcd_barrier(const XcdBarrier& b) {
  asm volatile("s_waitcnt vmcnt(0)" ::: "memory");
  __syncthreads();
  if (threadIdx.x == 0) {
    unsigned* bar = b.bar;
    __builtin_amdgcn_s_waitcnt(0);
    unsigned nloc = b.st[0], nx = b.st[1];
    if (nloc == 0u) { xcd_barrier_complete(bar, b.x, nloc, nx); b.st[0] = nloc; b.st[1] = nx; }
    const unsigned old = xb_add(&bar[XB_XSUB(b.x)], 1u);
    const unsigned gen = old / nloc;
    if (old + 1u == (gen + 1u) * nloc) {
      __builtin_amdgcn_fence(__ATOMIC_RELEASE, "agent");
      asm volatile("s_waitcnt vmcnt(0)" ::: "memory");
      const unsigned og = xb_add(&bar[XB_TOP], 1u);
      const unsigned tg = og / nx;
      if (og + 1u == (tg + 1u) * nx) xb_add(&bar[XB_TOPGEN], 1u);
      else XB_SPIN(xb_ld(&bar[XB_TOPGEN]) == tg, bar);
      __builtin_amdgcn_fence(__ATOMIC_ACQUIRE, "agent");
      xb_add(&bar[XB_XGEN(b.x)], 1u);
      asm volatile("s_waitcnt vmcnt(0)" ::: "memory");
    } else {
      XB_SPIN(xb_ld(&bar[XB_XGEN(b.x)]) == gen, bar);
      __builtin_amdgcn_fence(__ATOMIC_ACQUIRE, "agent");
      asm volatile("s_waitcnt vmcnt(0)" ::: "memory");
    }
  }
  __syncthreads();
}

struct XJob { int x, r, nrank; };
DI XJob xjob_init() { XJob j; j.x = blockIdx.x & 7; j.r = blockIdx.x >> 3; j.nrank = gridDim.x >> 3; return j; }
DI void xjob_map(const XJob& xj, int lj, int MT, int NT, int& mt, int& nt) {
  int mtx;
  if ((NT & 7) == 0) {
    const int p = lj >> 6, q = lj & 63, npn = NT >> 3;
    nt = (p % npn) * 8 + (q & 7);
    mtx = (p / npn) * 8 + (q >> 3);
  } else { mtx = lj / NT; nt = lj % NT; }
  mt = xj.x * (MT >> 3) + mtx;
}

__global__ void __launch_bounds__(256, 2) mega(Params p) {
  cg::grid_group grid = cg::this_grid();
  __shared__ __attribute__((aligned(16))) char smem[40960];
  h16* As = (h16*)smem;
  h16* Bs = (h16*)(smem + 18432);
  const int t = threadIdx.x;
  const int gw = __builtin_amdgcn_readfirstlane((int)(blockIdx.x * 4 + (t >> 6)));
  const int nw = gridDim.x * 4;
  const int gtid = blockIdx.x * 256 + t, gthreads = gridDim.x * 256;
  const int lane = t & 63;
  const XJob xj = xjob_init();

  char* D = (char*)p.out;
  char* W = p.ws;
  h16* x16 = (h16*)(D + D_X16);
  h16* bout = (h16*)(D + D_BOUT);
  h16* lorain = (h16*)(D + D_LORA);
  h16* g16 = (h16*)(D + D_G16);
  h16* Wt = (h16*)(W + W_WT);
  float* sb = (float*)(W + W_SB);
  float* pe = (float*)(W + W_PE);
  float* ybuf = (float*)(W + W_YBUF);
  h16* zpass = (h16*)(W + W_ZPASS);
  h16* zpa = (h16*)(W + W_ZPA);
  h16* zatt = (h16*)(W + W_ZATT);
  h16* pa = (h16*)(W + W_PA);
  h16* aout = (h16*)(W + W_AOUT);
  h16* cout_ = (h16*)(W + W_COUT);
  h16* merged = (h16*)(W + W_MERGED);
  h16* ypre1 = (h16*)(W + W_YPRE1);
  h16* hid = (h16*)(W + W_HID);
  h16* ypre2 = (h16*)(W + W_YPRE2);

  __shared__ u32x4 xb_words;
  if (threadIdx.x == 0) xb_words = u32x4{0u, 0u, 0u, 0u};
  __syncthreads();
  XcdBarrier xb = xcd_barrier_post((unsigned*)(W + W_BAR), (volatile LAS unsigned*)&xb_words);
  grid.sync();
#define SYNC() xcd_barrier(xb)

  if (PH(19)) for (int idx = blockIdx.x * 256 + otid(); idx < NTOK * 128; idx += gthreads) {
    const size_t e = (size_t)idx * 8;
    const float* src = e < (size_t)32768 * 1024 ? p.in[0] + e : p.in[1] + (e - (size_t)32768 * 1024);
    const float4 a = *(const float4*)src, b = *(const float4*)(src + 4);
    half8 o;
    o[0] = (h16)a.x; o[1] = (h16)a.y; o[2] = (h16)a.z; o[3] = (h16)a.w;
    o[4] = (h16)b.x; o[5] = (h16)b.y; o[6] = (h16)b.z; o[7] = (h16)b.w;
    *(half8*)&x16[e] = o;
  }

  for (int L = 0; L < 4; ++L) {
    if (PH(20)) {
      float* tile = (float*)smem;
      tconv(p.in[3] + (size_t)L * 1024 * 6272, Wt + WT_IN, 1024, 6272, tile);
      for (int b = 0; b < 3; ++b)
        tconv(p.in[18] + ((size_t)L * 3 + b) * 512 * 1024, Wt + WT_BR + (size_t)b * 1024 * 512, 512, 1024, tile);
      tconv(p.in[19] + (size_t)L * 1024 * 1024, Wt + WT_O, 1024, 1024, tile);
      tconv(p.in[22] + (size_t)L * 1024 * 4096, Wt + WT_F1, 1024, 4096, tile);
      tconv(p.in[23] + (size_t)L * 4096 * 1024, Wt + WT_F2, 4096, 1024, tile);
      for (int g = 0; g < 4; ++g)
        tconv(p.in[4] + ((size_t)L * 4 + g) * 128 * 128, Wt + WT_POOL + (size_t)g * 128 * 128, 128, 128, tile);
      for (int d = 0; d < 2; ++d) {
        tconv(p.in[8] + ((size_t)L * 2 + d) * 64 * 512, Wt + WT_W2 + (size_t)d * 512 * 64, 64, 512, tile);
        tconv(p.in[10] + ((size_t)L * 2 + d) * 64 * 512, Wt + WT_A2 + (size_t)d * 512 * 64, 64, 512, tile);
      }
      tconv(p.in[11] + (size_t)L * 128 * 512, Wt + WT_G2, 128, 512, tile);
    }
    SYNC();
    const float* mu = p.in[6] + (size_t)L * 1920;

    if (PH(1)) for (int lj = xj.r; lj < 64 * 3; lj += xj.nrank) {
      int mt, nt; xjob_map(xj, lj, 512, 3, mt, nt); const int m0 = mt * 128;
      floatx16 acc[2][2]; acc_zero<2>(acc);
      gemm_core<2>(x16 + (size_t)m0 * 1024, 1024, Wt + WT_IN + (size_t)(2048 + nt * 128) * 1024, 1024, 1024, acc, As, Bs);
      epi_apply<2>(acc, [&](int r, int c, float v) { zpass[(size_t)(m0 + r) * 384 + nt * 128 + c] = (h16)v; });
    }
    SYNC();
    if (PH(2)) for (int idx = blockIdx.x * 256 + otid(); idx < NTOK * 48; idx += gthreads) {
      const int tok = idx / 48, c0 = (idx % 48) * 8;
      int s0, len; seq_of(tok, s0, len);
      const half8 z = *(const half8*)&zpass[(size_t)tok * 384 + c0];
      const bool hp = tok > s0, hn = tok < s0 + len - 1;
      half8 zp = *(const half8*)&zpass[(size_t)(tok - (hp ? 1 : 0)) * 384 + c0];
      half8 zn = *(const half8*)&zpass[(size_t)(tok + (hn ? 1 : 0)) * 384 + c0];
#pragma unroll
      for (int j = 0; j < 8; ++j) { zp[j] = hp ? zp[j] : (h16)0.f; zn[j] = hn ? zn[j] : (h16)0.f; }
      half8 o;
#pragma unroll
      for (int j = 0; j < 8; ++j) {
        const float u0 = (float)z[j];
        const float u = u0 + mu[1536 + c0 + j] * (0.5f * ((float)zp[j] + (float)zn[j]) - u0);
        const float th = 1.f - 2.f * __builtin_amdgcn_rcpf(1.f + __expf(2.f * u));
        const float r = c0 < 128 ? th : (c0 < 256 ? u : sigmoidf_(u));
        o[j] = (h16)r;
      }
      *(half8*)&lorain[(size_t)tok * 384 + c0] = o;
    }
    SYNC();

    for (int ps = 0; ps < 4; ++ps) {
      const int njt = ps == 0 ? 8 : 5;
      if (PH(3)) for (int lj = xj.r; lj < 64 * njt; lj += xj.nrank) {
        const int mt = xj.x * 64 + lj / njt, jt = ps == 0 ? ((lj + (lj >> 6)) & 7) : 3 + lj % 5, m0 = mt * 128;
        floatx16 acc[2][2]; acc_zero<2>(acc);
        if (jt < 3) {
          gemm_core<2>(x16 + (size_t)m0 * 1024, 1024, Wt + WT_IN + (size_t)(512 + jt * 512 + 128 * ps) * 1024, 1024, 1024, acc, As, Bs);
          epi_apply<2>(acc, [&](int r, int c, float v) { zpass[(size_t)(m0 + r) * 384 + jt * 128 + c] = (h16)v; });
        } else if (jt < 5) {
          const int d = jt - 3;
          gemm_core<2>(lorain + (size_t)m0 * 384 + 64 * d, 384, Wt + WT_W2 + (size_t)(d * 512 + 128 * ps) * 64, 64, 64, acc, As, Bs);
          const float* w0 = p.in[7] + ((size_t)L * 2 + d) * 512 + 128 * ps;
          epi_apply<2>(acc, [&](int r, int c, float v) {
            const float x = -(w0[c] + v);
            const float sp = fmaxf(x, 0.f) + __logf(1.f + __expf(-fabsf(x)));
            const float dec = __expf(-__expf(-sp - 0.5f));
            sb[((size_t)(m0 + r) * 2 + (c >> 6)) * 352 + d * 64 + (c & 63)] = dec;
          });
        } else if (jt < 7) {
          const int d = jt - 5;
          gemm_core<2>(lorain + (size_t)m0 * 384 + 128 + 64 * d, 384, Wt + WT_A2 + (size_t)(d * 512 + 128 * ps) * 64, 64, 64, acc, As, Bs);
          const float* a0 = p.in[9] + ((size_t)L * 2 + d) * 512 + 128 * ps;
          epi_apply<2>(acc, [&](int r, int c, float v) {
            ((h16*)(sb + ((size_t)(m0 + r) * 2 + (c >> 6)) * 352 + 128))[192 + 128 * d + (c & 63)] = (h16)sigmoidf_(a0[c] + v);
          });
        } else {
          gemm_core<2>(lorain + (size_t)m0 * 384 + 256, 384, Wt + WT_G2 + (size_t)(128 * ps) * 128, 128, 128, acc, As, Bs);
          epi_apply<2>(acc, [&](int r, int c, float v) { g16[(size_t)(m0 + r) * 128 + c] = (h16)v; });
        }
      }
      SYNC();
      if (PH(4)) {
        const int lane = otid() & 63;
        const float* kk_w = p.in[12] + (size_t)L * 512 + 128 * ps;
        const float* ka_w = p.in[13] + (size_t)L * 512 + 128 * ps;
        float muc[2][3], kkc[2], kac[2];
#pragma unroll
        for (int hh = 0; hh < 2; ++hh) {
          const int cl = 64 * hh + lane;
#pragma unroll
          for (int q = 0; q < 3; ++q) muc[hh][q] = mu[q * 512 + 128 * ps + cl];
          kkc[hh] = kk_w[cl]; kac[hh] = ka_w[cl];
        }
        for (int tb = gw; tb < NTOK; tb += 2 * nw) {
          float z0[2][2][3], zm[2][2][3], zn[2][2][3], af[2][2], ab[2][2];
#pragma unroll
          for (int u = 0; u < 2; ++u) {
            const int tok = tb + u * nw;
            int s0, len; seq_of(tok, s0, len);
            const bool hp = tok > s0, hn = tok < s0 + len - 1;
            const h16* zp = zpass + (size_t)tok * 384;
#pragma unroll
            for (int hh = 0; hh < 2; ++hh) {
              const int cl = 64 * hh + lane;
#pragma unroll
              for (int q = 0; q < 3; ++q) {
                z0[u][hh][q] = (float)zp[q * 128 + cl];
                const float a_ = (float)zp[q * 128 + cl - (hp ? 384 : 0)];
                const float b_ = (float)zp[q * 128 + cl + (hn ? 384 : 0)];
                zm[u][hh][q] = hp ? a_ : 0.f; zn[u][hh][q] = hn ? b_ : 0.f;
              }
              const h16* sp = (const h16*)(sb + ((size_t)tok * 2 + hh) * 352 + 128);
              af[u][hh] = (float)sp[192 + lane]; ab[u][hh] = (float)sp[320 + lane];
            }
          }
#pragma unroll
          for (int u = 0; u < 2; ++u) {
            const int tok = tb + u * nw;
#pragma unroll
            for (int hh = 0; hh < 2; ++hh) {
              float uu[3];
#pragma unroll
              for (int q = 0; q < 3; ++q) uu[q] = z0[u][hh][q] + muc[hh][q] * (0.5f * (zm[u][hh][q] + zn[u][hh][q]) - z0[u][hh][q]);
              const float r = uu[0], k = uu[1], v = uu[2];
              const float kkr = k * kkc[hh];
              const float kk = kkr * __builtin_amdgcn_rsqf(fmaxf(wave_sum(kkr * kkr), 1e-24f));
              h16* sp = (h16*)(sb + ((size_t)tok * 2 + hh) * 352 + 128);
              const float ka = kac[hh], a1 = af[u][hh], a2 = ab[u][hh];
              sp[lane] = (h16)kk; sp[64 + lane] = (h16)r; sp[128 + lane] = (h16)v;
              sp[192 + lane] = (h16)(-kk * a1); sp[256 + lane] = (h16)(k * (1.f + (a1 - 1.f) * ka));
              sp[320 + lane] = (h16)(-kk * a2); sp[384 + lane] = (h16)(k * (1.f + (a2 - 1.f) * ka));
            }
          }
        }
      }
      SYNC();
      if (PH(5)) scan_l13<false>(sb, pe, ybuf, gw, nw);
      SYNC();
      if (PH(6)) {
        if (blockIdx.x < 72) scan_l2(pe, smem);
        else if (ps == 3) {
          const int r2 = (blockIdx.x - 72) >> 3, nr2 = (gridDim.x - 72) >> 3;
          for (int lj = r2; lj < 64 * 6; lj += nr2) {
            const int mt = xj.x * 64 + lj / 6, nt = lj % 6, m0 = mt * 128;
            floatx16 acc[2][2]; acc_zero<2>(acc);
            gemm_core<2>(x16 + (size_t)m0 * 1024, 1024, Wt + WT_IN + (size_t)(2432 + nt * 128) * 1024, 1024, 1024, acc, As, Bs);
            epi_apply<2>(acc, [&](int r, int c, float v) { zatt[(size_t)(m0 + r) * 768 + nt * 128 + c] = (h16)v; });
          }
        } else {
          const int r2 = (blockIdx.x - 72) >> 3, nr2 = (gridDim.x - 72) >> 3;
          for (int lj = r2; lj < 64 * 3; lj += nr2) {
            const int mt = xj.x * 64 + lj / 3, jt = lj % 3, m0 = mt * 128;
            floatx16 acc[2][2]; acc_zero<2>(acc);
            gemm_core<2>(x16 + (size_t)m0 * 1024, 1024, Wt + WT_IN + (size_t)(512 + jt * 512 + 128 * (ps + 1)) * 1024, 1024, 1024, acc, As, Bs);
            epi_apply<2>(acc, [&](int r, int c, float v) { zpass[(size_t)(m0 + r) * 384 + jt * 128 + c] = (h16)v; });
          }
        }
      }
      SYNC();
      if (PH(7)) scan_l13<true>(sb, pe, ybuf, gw, nw);
      SYNC();
      if (PH(8)) {
        const int lane = otid() & 63;
        const float* rk = p.in[14] + (size_t)L * 512 + 128 * ps;
        const float* gng = p.in[15] + (size_t)L * 512 + 128 * ps;
        const float* gnb = p.in[16] + (size_t)L * 512 + 128 * ps;
        float rkc[2], ggc[2], gbc[2];
#pragma unroll
        for (int hh = 0; hh < 2; ++hh) { rkc[hh] = rk[64 * hh + lane]; ggc[hh] = gng[64 * hh + lane]; gbc[hh] = gnb[64 * hh + lane]; }
        for (int tb = gw; tb < NTOK; tb += 2 * nw) {
          float yv[2][2], rr[2][2], vv[2][2], kb_[2][2], gg[2][2];
#pragma unroll
          for (int u = 0; u < 2; ++u) {
            const int tok = tb + u * nw;
#pragma unroll
            for (int hh = 0; hh < 2; ++hh) {
              const int cl = 64 * hh + lane;
              yv[u][hh] = ybuf[(size_t)tok * 128 + cl] + ybuf[((size_t)NTOK + tok) * 128 + cl];
              const h16* sp = (const h16*)(sb + ((size_t)tok * 2 + hh) * 352 + 128);
              rr[u][hh] = (float)sp[64 + lane]; vv[u][hh] = (float)sp[128 + lane];
              kb_[u][hh] = 0.5f * ((float)sp[256 + lane] + (float)sp[384 + lane]);
              gg[u][hh] = (float)g16[(size_t)tok * 128 + cl];
            }
          }
#pragma unroll
          for (int u = 0; u < 2; ++u) {
            const int tok = tb + u * nw;
#pragma unroll
            for (int hh = 0; hh < 2; ++hh) {
              const int cl = 64 * hh + lane;
              const float y = yv[u][hh];
              const float mean = wave_sum(y) * (1.f / 64.f);
              const float dy = y - mean;
              const float var = wave_sum(dy * dy) * (1.f / 64.f);
              const float yn = dy * rsqrtf(var + 64e-5f) * ggc[hh] + gbc[hh];
              const float bs = wave_sum(rr[u][hh] * kb_[u][hh] * rkc[hh]);
              const float o = (yn + bs * vv[u][hh]) * gg[u][hh];
              bout[(size_t)tok * 512 + 128 * ps + cl] = (h16)o;
            }
          }
        }
      }
      SYNC();
    }

    if (PH(9)) for (int lj = xj.r; lj < 64 * 4; lj += xj.nrank) {
      int mt, nt; xjob_map(xj, lj, 512, 4, mt, nt); const int m0 = mt * 128;
      const int wrow = nt * 128;
      floatx16 acc[2][2]; acc_zero<2>(acc);
      gemm_core<2>(x16 + (size_t)m0 * 1024, 1024, Wt + WT_IN + (size_t)wrow * 1024, 1024, 1024, acc, As, Bs);
      epi_apply<2>(acc, [&](int r, int c, float v) { zpa[(size_t)(m0 + r) * 512 + nt * 128 + c] = (h16)v; });
    }
    SYNC();
    if (PH(10)) for (int idx = blockIdx.x * 256 + otid(); idx < NTOK * 64; idx += gthreads) {
      const int tok = idx >> 6, c0 = (idx & 63) * 8;
      int s0, len; seq_of(tok, s0, len);
      const int wd = 2 << (c0 >> 7);
      const int pos = tok - s0;
      const int lo = max(pos - wd / 2, 0), hi = min(pos + wd / 2 - 1, len - 1);
      float sum[8];
#pragma unroll
      for (int j = 0; j < 8; ++j) sum[j] = 0.f;
#pragma unroll
      for (int k = 0; k < 16; ++k) {
        const int tt = lo + k;
        const bool ok = tt <= hi;
        const half8 z = *(const half8*)&zpa[(size_t)(s0 + (ok ? tt : hi)) * 512 + c0];
#pragma unroll
        for (int j = 0; j < 8; ++j) sum[j] += ok ? (float)z[j] : 0.f;
      }
      const half8 zc = *(const half8*)&zpa[(size_t)tok * 512 + c0];
      const float ic = __builtin_amdgcn_rcpf((float)(hi - lo + 1));
      half8 o;
#pragma unroll
      for (int j = 0; j < 8; ++j) o[j] = (h16)(sum[j] * ic - (float)zc[j]);
      *(half8*)&pa[(size_t)tok * 512 + c0] = o;
    }
    if (PH(11)) for (int item = blockIdx.x; item < 4096; item += gridDim.x)
      attn_item(item, zatt, cout_, p.in[2], p.in[17] + (size_t)L * 8, (h16*)smem, (h16*)(smem + 18432), (float*)(smem + 18432 + 17408));
    SYNC();
    if (PH(12)) for (int lj = xj.r; lj < 64 * 4; lj += xj.nrank) {
      int mt, g; xjob_map(xj, lj, 512, 4, mt, g); const int m0 = mt * 128;
      floatx16 acc[2][2]; acc_zero<2>(acc);
      gemm_core<2>(pa + (size_t)m0 * 512 + 128 * g, 512, Wt + WT_POOL + (size_t)g * 128 * 128, 128, 128, acc, As, Bs);
      const float* psc = p.in[5] + (size_t)L * 512 + 128 * g;
      epi_apply<2>(acc, [&](int r, int c, float v) { aout[(size_t)(m0 + r) * 512 + 128 * g + c] = (h16)(v * psc[c]); });
    }
    SYNC();
    if (PH(13)) for (int lj = xj.r; lj < 64 * 16; lj += xj.nrank) {
      int mt, nt; xjob_map(xj, lj, 512, 16, mt, nt); const int m0 = mt * 128, n0 = nt * 64;
      floatx16 mg[2][1]; acc_zero<1>(mg);
      for (int b = 0; b < 3; ++b) {
        floatx16 ag[2][1]; acc_zero<1>(ag);
        gemm_core<1>(x16 + (size_t)m0 * 1024, 1024, Wt + WT_IN + (size_t)(3200 + 1024 * b + n0) * 1024, 1024, 1024, ag, As, Bs);
        floatx16 ap[2][1]; acc_zero<1>(ap);
        const h16* br = b == 0 ? aout : (b == 1 ? bout : cout_);
        gemm_core<1>(br + (size_t)m0 * 512, 512, Wt + WT_BR + (size_t)(b * 1024 + n0) * 512, 512, 512, ap, As, Bs);
#pragma unroll
        for (int i = 0; i < 2; ++i)
#pragma unroll
          for (int r = 0; r < 16; ++r) mg[i][0][r] += sigmoidf_(ag[i][0][r]) * ap[i][0][r];
      }
      epi_apply<1>(mg, [&](int r, int c, float v) { merged[(size_t)(m0 + r) * 1024 + n0 + c] = (h16)v; });
    }
    SYNC();
    if (PH(14)) for (int lj = xj.r; lj < 64 * 8; lj += xj.nrank) {
      int mt, nt; xjob_map(xj, lj, 512, 8, mt, nt); const int m0 = mt * 128, n0 = nt * 128;
      floatx16 acc[2][2]; acc_zero<2>(acc);
      gemm_core<2>(merged + (size_t)m0 * 1024, 1024, Wt + WT_O + (size_t)n0 * 1024, 1024, 1024, acc, As, Bs);
      epi_apply<2>(acc, [&](int r, int c, float v) {
        const size_t o = (size_t)(m0 + r) * 1024 + n0 + c;
        ypre1[o] = (h16)(ALPHA * (float)x16[o] + v);
      });
    }
    SYNC();
    if (PH(15)) ln_phase(ypre1, p.in[20] + (size_t)L * 1024, p.in[21] + (size_t)L * 1024, x16, nullptr, false, gw, nw);
    SYNC();
    for (int hf = 0; hf < 4; ++hf) {
      if (PH(16)) for (int lj = xj.r; lj < 16 * 32; lj += xj.nrank) {
        int mt, nt; xjob_map(xj, lj, 128, 32, mt, nt); const int m0 = mt * 128, n0 = nt * 128;
        floatx16 acc[2][2]; acc_zero<2>(acc);
        gemm_core<2>(x16 + (size_t)(hf * 16384 + m0) * 1024, 1024, Wt + WT_F1 + (size_t)n0 * 1024, 1024, 1024, acc, As, Bs);
        epi_apply<2>(acc, [&](int r, int c, float v) {
          const float u = fmaxf(v, 0.f);
          hid[(size_t)(m0 + r) * 4096 + n0 + c] = (h16)(u * u);
        });
      }
      SYNC();
      if (PH(17)) for (int lj = xj.r; lj < 16 * 8; lj += xj.nrank) {
        int mt, nt; xjob_map(xj, lj, 128, 8, mt, nt); const int m0 = mt * 128, n0 = nt * 128;
        floatx16 acc[2][2]; acc_zero<2>(acc);
        gemm_core<2>(hid + (size_t)m0 * 4096, 4096, Wt + WT_F2 + (size_t)n0 * 4096, 4096, 4096, acc, As, Bs);
        epi_apply<2>(acc, [&](int r, int c, float v) {
          const size_t o = (size_t)(hf * 16384 + m0 + r) * 1024 + n0 + c;
          ypre2[o] = (h16)(ALPHA * (float)x16[o] + v);
        });
      }
      SYNC();
    }
    if (PH(18)) ln_phase(ypre2, p.in[24] + (size_t)L * 1024, p.in[25] + (size_t)L * 1024, x16, p.out, L == 3, gw, nw);
    SYNC();
  }
}

extern "C" void kernel_launch(void* const* d_in, const int* in_sizes, int n_in, void* d_out, int out_size,
                              void* d_ws, size_t ws_size, hipStream_t stream) {
  static int grid_blocks = 0;
  if (!grid_blocks) {
    int dev = 0, cus = 0, per_cu = 0;
    hipGetDevice(&dev);
    hipDeviceGetAttribute(&cus, hipDeviceAttributeMultiprocessorCount, dev);
    hipOccupancyMaxActiveBlocksPerMultiprocessor(&per_cu, mega, 256, 0);
    if (per_cu > 2) per_cu = 2;
    if (per_cu < 1) per_cu = 1;
    grid_blocks = cus * per_cu;
  }
  Params p{};
  for (int i = 0; i < 26; ++i) p.in[i] = (const float*)d_in[i];
  p.out = (float*)d_out;
  p.ws = (char*)d_ws;
  hipMemsetAsync((char*)d_ws + W_BAR, 0, XCD_BAR_WORDS * sizeof(unsigned), stream);
  void* args[] = {&p};
  hipError_t e = hipLaunchCooperativeKernel((void*)mega, dim3(grid_blocks), dim3(256), args, 0, stream);
  if (e != hipSuccess) fprintf(stderr, "cooperative launch failed: %s (grid %d)\n", hipGetErrorString(e), grid_blocks);
}
```

```cpp
#include <hip/hip_runtime.h>
#include <hip/hip_fp16.h>
#include <hip/hip_cooperative_groups.h>
#include <cstdio>
#include <cstdint>
namespace cg = cooperative_groups;

typedef _Float16 h16;
typedef _Float16 half8 __attribute__((ext_vector_type(8)));
typedef _Float16 half4 __attribute__((ext_vector_type(4)));
typedef float floatx16 __attribute__((ext_vector_type(16)));
typedef float floatx4 __attribute__((ext_vector_type(4)));
typedef float float2v __attribute__((ext_vector_type(2)));
typedef unsigned int u32x4 __attribute__((ext_vector_type(4)));
typedef const __attribute__((address_space(4))) float2v* cf2p;

#define DI __device__ __forceinline__
#ifdef ONLY
#define PH(n) (ONLY == (n))
#else
#define PH(n) true
#endif

struct Params {
  const float* in[26];
  float* out;
  char* ws;
};

constexpr int NTOK = 65536;
constexpr size_t MiB = 1ull << 20;
constexpr size_t D_X16 = 0, D_BOUT = 128 * MiB, D_LORA = 192 * MiB, D_G16 = 240 * MiB;
constexpr size_t W_WT = 0;
constexpr size_t W_SB = 36 * MiB, W_PE = 324 * MiB, W_YBUF = 388 * MiB, W_ZPASS = 452 * MiB;
constexpr size_t W_ZPA = 36 * MiB, W_PA = 100 * MiB, W_AOUT = 260 * MiB, W_COUT = 324 * MiB, W_ZATT = 212 * MiB;
constexpr size_t W_MERGED = 36 * MiB, W_YPRE1 = 164 * MiB;
constexpr size_t W_HID = 36 * MiB, W_YPRE2 = 292 * MiB;
constexpr size_t W_BAR = 504 * MiB;
constexpr size_t WT_IN = 0, WT_BR = 6422528, WT_O = 7995392, WT_F1 = 9043968, WT_F2 = 13238272,
                 WT_POOL = 17432576, WT_W2 = 17498112, WT_A2 = 17563648, WT_G2 = 17629184;

constexpr float ALPHA = 1.681792830507429f;

DI void seq_of(int tok, int& s0, int& len) {
  if (tok < 32768) { s0 = tok & ~2047; len = 2048; }
  else { s0 = 32768 + ((tok - 32768) & ~16383); len = 16384; }
}
DI int otid() { int t = threadIdx.x; asm volatile("" : "+v"(t)); return t; }
template <int CTRL> DI float dppf(float v) {
  return __builtin_bit_cast(float, __builtin_amdgcn_mov_dpp(__builtin_bit_cast(int, v), CTRL, 0xf, 0xf, true));
}
DI float wave_sum(float v) {
  v += dppf<0xB1>(v);
  v += dppf<0x4E>(v);
  v += dppf<0x141>(v);
  v += dppf<0x140>(v);
  v += __builtin_bit_cast(float, __builtin_amdgcn_ds_swizzle(__builtin_bit_cast(int, v), 0x401F));
  const float a = __builtin_bit_cast(float, __builtin_amdgcn_readlane(__builtin_bit_cast(int, v), 0));
  const float b = __builtin_bit_cast(float, __builtin_amdgcn_readlane(__builtin_bit_cast(int, v), 32));
  return a + b;
}
DI float sigmoidf_(float x) { return __builtin_amdgcn_rcpf(1.f + __expf(-x)); }
DI float2v fma2(float2v a, float2v b, float2v c) { return __builtin_elementwise_fma(a, b, c); }

DI void tconv(const float* __restrict__ src, h16* __restrict__ dst, int K, int N, float* tile) {
  const int tn = N >> 6, tk = K >> 6, t = otid();
  for (int job = blockIdx.x; job < tk * tn; job += gridDim.x) {
    const int k0 = (job / tn) << 6, n0 = (job % tn) << 6;
    __syncthreads();
#pragma unroll
    for (int i = 0; i < 4; ++i) {
      const int k = (t >> 4) + 16 * i, n4 = (t & 15) * 4;
      const float4 v = *(const float4*)&src[(size_t)(k0 + k) * N + n0 + n4];
      tile[k * 65 + n4 + 0] = v.x; tile[k * 65 + n4 + 1] = v.y;
      tile[k * 65 + n4 + 2] = v.z; tile[k * 65 + n4 + 3] = v.w;
    }
    __syncthreads();
    const int n = t >> 2, ks = (t & 3) * 16;
    half8 o0, o1;
#pragma unroll
    for (int j = 0; j < 8; ++j) {
      o0[j] = (h16)tile[(ks + j) * 65 + n];
      o1[j] = (h16)tile[(ks + 8 + j) * 65 + n];
    }
    *(half8*)&dst[(size_t)(n0 + n) * K + k0 + ks] = o0;
    *(half8*)&dst[(size_t)(n0 + n) * K + k0 + ks + 8] = o1;
  }
}

template <int NJ>
DI void gemm_core(const h16* __restrict__ A, int lda, const h16* __restrict__ Bt, int ldb, int K,
                  floatx16 (&acc)[2][NJ], h16* As, h16* Bs) {
  const int t = otid(), l = t & 63, w = t >> 6, wm = w >> 1, wn = w & 1, h = l >> 5, lr = l & 31;
  u32x4 ra0[4], rb0[2 * NJ], ra1[4], rb1[2 * NJ];
  const h16* Ap = A + (size_t)(t >> 3) * lda + (t & 7) * 8;
  const h16* Bp = Bt + (size_t)(t >> 3) * ldb + (t & 7) * 8;
  const size_t sa = (size_t)32 * lda, sbb = (size_t)32 * ldb;
#define G_LOAD(RA, RB, k_) do { \
    _Pragma("unroll") for (int i = 0; i < 4; ++i) RA[i] = *(const u32x4*)&Ap[i * sa + (k_)]; \
    _Pragma("unroll") for (int i = 0; i < 2 * NJ; ++i) RB[i] = *(const u32x4*)&Bp[i * sbb + (k_)]; } while (0)
#define G_STEP(RA, RB, kn_) do { \
    __syncthreads(); \
    _Pragma("unroll") for (int i = 0; i < 4; ++i) *(u32x4*)&As[((t >> 3) + 32 * i) * 72 + (t & 7) * 8] = RA[i]; \
    _Pragma("unroll") for (int i = 0; i < 2 * NJ; ++i) *(u32x4*)&Bs[((t >> 3) + 32 * i) * 72 + (t & 7) * 8] = RB[i]; \
    __syncthreads(); \
    if ((kn_) < K) G_LOAD(RA, RB, kn_); \
    { half8 a[2][2], b[2][NJ]; \
      _Pragma("unroll") for (int i = 0; i < 2; ++i) a[0][i] = *(const half8*)&As[(wm * 64 + i * 32 + lr) * 72 + h * 8]; \
      _Pragma("unroll") for (int j = 0; j < NJ; ++j) b[0][j] = *(const half8*)&Bs[(wn * 32 * NJ + j * 32 + lr) * 72 + h * 8]; \
      _Pragma("unroll") for (int s = 0; s < 4; ++s) { \
        if (s < 3) { \
          _Pragma("unroll") for (int i = 0; i < 2; ++i) a[(s + 1) & 1][i] = *(const half8*)&As[(wm * 64 + i * 32 + lr) * 72 + (s + 1) * 16 + h * 8]; \
          _Pragma("unroll") for (int j = 0; j < NJ; ++j) b[(s + 1) & 1][j] = *(const half8*)&Bs[(wn * 32 * NJ + j * 32 + lr) * 72 + (s + 1) * 16 + h * 8]; \
        } \
        __builtin_amdgcn_sched_barrier(0); \
        _Pragma("unroll") for (int i = 0; i < 2; ++i) \
          _Pragma("unroll") for (int j = 0; j < NJ; ++j) \
            acc[i][j] = __builtin_amdgcn_mfma_f32_32x32x16_f16(a[s & 1][i], b[s & 1][j], acc[i][j], 0, 0, 0); \
        __builtin_amdgcn_sched_barrier(0); \
      } } } while (0)
  G_LOAD(ra0, rb0, 0);
  if (64 < K) G_LOAD(ra1, rb1, 64);
  for (int k0 = 0; k0 < K; k0 += 128) {
    G_STEP(ra0, rb0, k0 + 128);
    if (k0 + 64 < K) G_STEP(ra1, rb1, k0 + 192);
  }
#undef G_LOAD
#undef G_STEP
}
template <int NJ>
DI void acc_zero(floatx16 (&acc)[2][NJ]) {
#pragma unroll
  for (int i = 0; i < 2; ++i)
#pragma unroll
    for (int j = 0; j < NJ; ++j)
#pragma unroll
      for (int r = 0; r < 16; ++r) acc[i][j][r] = 0.f;
}
template <int NJ, class F>
DI void epi_apply(const floatx16 (&acc)[2][NJ], F f) {
  const int t = otid(), l = t & 63, w = t >> 6, wm = w >> 1, wn = w & 1, h = l >> 5, lr = l & 31;
#pragma unroll
  for (int i = 0; i < 2; ++i)
#pragma unroll
    for (int j = 0; j < NJ; ++j)
#pragma unroll
      for (int r = 0; r < 16; ++r) {
        f(wm * 64 + i * 32 + (r & 3) + 8 * (r >> 2) + 4 * h, wn * 32 * NJ + j * 32 + lr, acc[i][j][r]);
        if ((r & 3) == 3) __builtin_amdgcn_sched_barrier(0);
      }
}

DI void attn_item(int item, const h16* __restrict__ zpa, h16* __restrict__ cout, const float* __restrict__ rel_bias,
                  const float* __restrict__ sink_l, h16* Ks, h16* Vt, float* bt) {
  const int t = otid(), l = t & 63, w = t >> 6, h = l >> 5, lr = l & 31;
  const int hq = item & 7, qb = item >> 3;
  const int tok0 = qb * 128;
  int s0, len; seq_of(tok0, s0, len);
  const int nb = (tok0 - s0) >> 7, nblk = len >> 7;
  const int kvh = hq >> 2;
  __syncthreads();
  for (int r = t; r < 257; r += 256) {
    const int rel = r - 128;
    const int n = rel < 0 ? -rel : rel;
    int bk = n < 8 ? n : 8 + (n >= 12) + (n >= 16) + (n >= 23) + (n >= 32) + (n >= 46) + (n >= 64) + (n >= 91);
    if (rel > 0) bk += 16;
    bt[r] = rel_bias[bk * 8 + hq];
  }
  const int ql = w * 32 + lr;
  const int qtok = tok0 + ql;
  half8 qf[4];
#pragma unroll
  for (int ds = 0; ds < 4; ++ds) qf[ds] = *(const half8*)&zpa[(size_t)qtok * 768 + hq * 64 + ds * 16 + h * 8];
  float m = sink_l[hq], lsum = 1.f;
  floatx16 O[2];
#pragma unroll
  for (int dt = 0; dt < 2; ++dt)
#pragma unroll
    for (int r = 0; r < 16; ++r) O[dt][r] = 0.f;
  for (int kb = 0; kb < 3; ++kb) {
    const int kblk = nb - 1 + kb;
    if (kblk < 0 || kblk >= nblk) continue;
    const int ktok0 = s0 + kblk * 128;
    __syncthreads();
#pragma unroll
    for (int i = 0; i < 4; ++i) {
      const int c = t + 256 * i, key = c >> 3, seg = c & 7;
      const u32x4 kv = *(const u32x4*)&zpa[(size_t)(ktok0 + key) * 768 + 512 + kvh * 64 + seg * 8];
      *(u32x4*)&Ks[key * 72 + seg * 8] = kv;
      const half8 vv = *(const half8*)&zpa[(size_t)(ktok0 + key) * 768 + 640 + kvh * 64 + seg * 8];
      const int kl = key & 31;
      const int pos = (key & ~31) + (kl & 16) + ((kl >> 2) & 1) * 8 + ((kl >> 3) & 1) * 4 + (kl & 3);
#pragma unroll
      for (int e = 0; e < 8; ++e) Vt[(seg * 8 + e) * 136 + pos] = vv[e];
    }
    __syncthreads();
    floatx16 sc[4];
#pragma unroll
    for (int kt = 0; kt < 4; ++kt) {
#pragma unroll
      for (int r = 0; r < 16; ++r) sc[kt][r] = 0.f;
#pragma unroll
      for (int ds = 0; ds < 4; ++ds) {
        const half8 kf = *(const half8*)&Ks[(kt * 32 + lr) * 72 + ds * 16 + h * 8];
        sc[kt] = __builtin_amdgcn_mfma_f32_32x32x16_f16(kf, qf[ds], sc[kt], 0, 0, 0);
      }
    }
    float bmax = -1e30f;
#pragma unroll
    for (int kt = 0; kt < 4; ++kt)
#pragma unroll
      for (int r = 0; r < 16; ++r) {
        const int keyl = kt * 32 + (r & 3) + 8 * (r >> 2) + 4 * h;
        const int rel = (kb - 1) * 128 + keyl - ql;
        const bool ok = (rel >= -128) && (rel <= 128);
        const int ri = ok ? rel + 128 : 128;
        const float sv = ok ? sc[kt][r] * 0.125f + bt[ri] : -1e30f;
        sc[kt][r] = sv;
        bmax = fmaxf(bmax, sv);
      }
    bmax = fmaxf(bmax, __shfl_xor(bmax, 32));
    const float mnew = fmaxf(m, bmax);
    const float scale = __expf(m - mnew);
    float psum = 0.f;
#pragma unroll
    for (int kt = 0; kt < 4; ++kt)
#pragma unroll
      for (int r = 0; r < 16; ++r) {
        const float pv = __expf(sc[kt][r] - mnew);
        sc[kt][r] = pv;
        psum += pv;
      }
    psum += __shfl_xor(psum, 32);
    lsum = lsum * scale + psum;
    m = mnew;
#pragma unroll
    for (int dt = 0; dt < 2; ++dt)
#pragma unroll
      for (int r = 0; r < 16; ++r) O[dt][r] *= scale;
#pragma unroll
    for (int kt = 0; kt < 4; ++kt)
#pragma unroll
      for (int s = 0; s < 2; ++s) {
        half8 pf;
#pragma unroll
        for (int j = 0; j < 8; ++j) pf[j] = (h16)sc[kt][8 * s + j];
#pragma unroll
        for (int dt = 0; dt < 2; ++dt) {
          const half8 vf = *(const half8*)&Vt[(dt * 32 + lr) * 136 + kt * 32 + s * 16 + h * 8];
          O[dt] = __builtin_amdgcn_mfma_f32_32x32x16_f16(vf, pf, O[dt], 0, 0, 0);
        }
      }
  }
  const float inv = 1.f / lsum;
#pragma unroll
  for (int dt = 0; dt < 2; ++dt)
#pragma unroll
    for (int g = 0; g < 4; ++g) {
      half4 o;
#pragma unroll
      for (int e = 0; e < 4; ++e) o[e] = (h16)(O[dt][4 * g + e] * inv);
      *(half4*)&cout[(size_t)qtok * 512 + hq * 64 + dt * 32 + 8 * g + 4 * h] = o;
    }
}

template <int N> DI void fmac_bc(float& acc, float vec, float s) {
  asm("v_fmac_f32_dpp %0, %1, %2 row_newbcast:%3 row_mask:0xf bank_mask:0xf" : "+v"(acc) : "v"(vec), "v"(s), "i"(N));
}
template <int N> DI float mul_bc(float vec, float s) {
  float r;
  asm("v_mul_f32_dpp %0, %1, %2 row_newbcast:%3 row_mask:0xf bank_mask:0xf" : "=v"(r) : "v"(vec), "v"(s), "i"(N));
  return r;
}
struct ScanIn { floatx4 kk, w, nb, kd, r; float vi; };
struct ScanRaw { half4 kk, nb, kd, r; floatx4 w; h16 vi; };
DI floatx4 h4f(half4 v) { return floatx4{(float)v[0], (float)v[1], (float)v[2], (float)v[3]}; }
DI void pin4(floatx4& v) {
  float a = v[0], b = v[1], c = v[2], d = v[3];
  asm volatile("" : "+v"(a), "+v"(b), "+v"(c), "+v"(d));
  v = floatx4{a, b, c, d};
}
template <int MODE>
DI ScanRaw scan_ld(const float* __restrict__ sb, int c, int hh, int d, int s, unsigned o, unsigned lane) {
  const int tok = c * 128 + (d ? 127 - s : s);
  const float* p = sb + ((size_t)tok * 2 + hh) * 352;
  const h16* ph = (const h16*)(p + 128);
  const h16* pdh = ph + d * 128;
  ScanRaw in;
  in.kk = *(const half4*)&ph[o];
  in.w = *(const floatx4*)&p[d * 64 + o];
  in.nb = *(const half4*)&pdh[192 + o];
  if (MODE != 1) { in.kd = *(const half4*)&pdh[256 + o]; in.vi = ph[128 + lane]; }
  if (MODE == 2) in.r = *(const half4*)&ph[64 + o];
  return in;
}
#define SCAN_R4(M, b) M(b) M(b + 1) M(b + 2) M(b + 3)
#define SCAN_R16(M, b) SCAN_R4(M, b) SCAN_R4(M, b + 4) SCAN_R4(M, b + 8) SCAN_R4(M, b + 12)
#define SCAN_R64(M) SCAN_R16(M, 0) SCAN_R16(M, 16) SCAN_R16(M, 32) SCAN_R16(M, 48)
#define DPPM " row_newbcast:%9 row_mask:0xf bank_mask:0xf\n\t"
template <int N, int MODE>
DI void upd_elem(float& Sj, float& y, float nbc, float kdc, float wc, float rc, float dot, float vi) {
  float t;
  if (MODE == 2)
    asm("v_mul_f32_dpp %0, %3, %7" DPPM "v_fmac_f32_dpp %0, %4, %8" DPPM "v_fmac_f32_dpp %0, %5, %2" DPPM "v_fmac_f32_dpp %1, %6, %0" DPPM
        : "=&v"(t), "+v"(y) : "v"(Sj), "v"(nbc), "v"(kdc), "v"(wc), "v"(rc), "v"(dot), "v"(vi), "i"(N));
  else if (MODE == 0)
    asm("v_mul_f32_dpp %0, %3, %7" DPPM "v_fmac_f32_dpp %0, %4, %8" DPPM "v_fmac_f32_dpp %0, %5, %2" DPPM
        : "=&v"(t), "+v"(y) : "v"(Sj), "v"(nbc), "v"(kdc), "v"(wc), "v"(wc), "v"(dot), "v"(vi), "i"(N));
  else
    asm("v_mul_f32_dpp %0, %3, %7" DPPM "v_fmac_f32_dpp %0, %5, %2" DPPM
        : "=&v"(t), "+v"(y) : "v"(Sj), "v"(nbc), "v"(nbc), "v"(wc), "v"(wc), "v"(dot), "v"(dot), "i"(N));
  Sj = t;
}
template <int MODE>
DI float scan_step(float (&S)[64], const ScanRaw& raw) {
  ScanIn in;
  in.kk = h4f(raw.kk); in.w = raw.w; in.nb = h4f(raw.nb);
  if (MODE != 1) { in.kd = h4f(raw.kd); in.vi = (float)raw.vi; }
  if (MODE == 2) in.r = h4f(raw.r);
  pin4(in.kk); pin4(in.w); pin4(in.nb);
  if (MODE != 1) { pin4(in.kd); asm volatile("" : "+v"(in.vi)); }
  if (MODE == 2) pin4(in.r);
  __builtin_amdgcn_sched_barrier(0);
  asm volatile("s_nop 4");
  float dd[8], yy[8];
#pragma unroll
  for (int k = 0; k < 8; ++k) { dd[k] = 0.f; yy[k] = 0.f; }
#define SC_DOT(j) fmac_bc<((j) >> 2)>(dd[(j) & 7], in.kk[(j) & 3], S[j]);
  SCAN_R64(SC_DOT)
  const float dot = ((dd[0] + dd[1]) + (dd[2] + dd[3])) + ((dd[4] + dd[5]) + (dd[6] + dd[7]));
#define SC_E(j) upd_elem<((j) >> 2), MODE>(S[j], yy[(j) & 7], in.nb[(j) & 3], in.kd[(j) & 3], in.w[(j) & 3], in.r[(j) & 3], dot, in.vi);
  SCAN_R64(SC_E)
  __builtin_amdgcn_sched_barrier(0);
  return ((yy[0] + yy[1]) + (yy[2] + yy[3])) + ((yy[4] + yy[5]) + (yy[6] + yy[7]));
}
template <int MODE>
DI void scan_item(const float* __restrict__ sb, float* __restrict__ pe, float* __restrict__ ybuf, int item, int lane) {
  const int c = item >> 2, hh = (item >> 1) & 1, d = item & 1;
  float S[64];
  float* pbase = pe + (size_t)item * 8192;
  if (MODE == 2) {
#pragma unroll
    for (int j = 0; j < 16; ++j) {
      const floatx4 v = *(const floatx4*)&pbase[4096 + lane * 64 + 4 * j];
      S[4 * j] = v[0]; S[4 * j + 1] = v[1]; S[4 * j + 2] = v[2]; S[4 * j + 3] = v[3];
    }
  } else {
#pragma unroll
    for (int j = 0; j < 64; ++j) S[j] = (MODE == 1 && j == lane) ? 1.f : 0.f;
  }
  float* yout = ybuf + (size_t)d * NTOK * 128 + hh * 64 + lane;
  const unsigned o = 4u * (lane & 15), ul = lane;
  ScanRaw r0 = scan_ld<MODE>(sb, c, hh, d, 0, o, ul), r1 = scan_ld<MODE>(sb, c, hh, d, 1, o, ul), r2 = scan_ld<MODE>(sb, c, hh, d, 2, o, ul);
  for (int s = 0; s < 128; s += 4) {
    ScanRaw r3 = scan_ld<MODE>(sb, c, hh, d, s + 3, o, ul);
    float y = scan_step<MODE>(S, r0);
    if (MODE == 2) yout[(size_t)(c * 128 + (d ? 127 - s : s)) * 128] = y;
    r0 = scan_ld<MODE>(sb, c, hh, d, min(s + 4, 127), o, ul);
    y = scan_step<MODE>(S, r1);
    if (MODE == 2) yout[(size_t)(c * 128 + (d ? 126 - s : s + 1)) * 128] = y;
    r1 = scan_ld<MODE>(sb, c, hh, d, min(s + 5, 127), o, ul);
    y = scan_step<MODE>(S, r2);
    if (MODE == 2) yout[(size_t)(c * 128 + (d ? 125 - s : s + 2)) * 128] = y;
    r2 = scan_ld<MODE>(sb, c, hh, d, min(s + 6, 127), o, ul);
    y = scan_step<MODE>(S, r3);
    if (MODE == 2) yout[(size_t)(c * 128 + (d ? 124 - s : s + 3)) * 128] = y;
  }
  if (MODE == 0) {
    float* o = pbase + 4096 + lane * 64;
#pragma unroll
    for (int j = 0; j < 16; ++j) *(floatx4*)&o[4 * j] = floatx4{S[4 * j], S[4 * j + 1], S[4 * j + 2], S[4 * j + 3]};
  }
  if (MODE == 1) {
    h16* pf = (h16*)pbase + (((lane >> 5) * 64 + ((lane >> 2) & 3) * 16) * 8 + 4 * ((lane >> 4) & 1) + (lane & 3));
#pragma unroll
    for (int j = 0; j < 64; ++j) pf[(j >> 4) * 1024 + (j & 15) * 8] = (h16)S[j];
  }
}
template <bool L3>
DI void scan_l13(const float* __restrict__ sb, float* __restrict__ pe, float* __restrict__ ybuf, int gw, int nw) {
  const int lane = otid() & 63;
  if (L3) {
    for (int item = gw; item < 2048; item += nw) scan_item<2>(sb, pe, ybuf, item, lane);
  } else {
    for (int it = gw; it < 2048; it += nw) scan_item<0>(sb, pe, ybuf, it, lane);
    for (int it = gw; it < 2048; it += nw) scan_item<1>(sb, pe, ybuf, it, lane);
  }
}

DI void scan_l2(float* __restrict__ pe, char* lds) {
  const int t = otid(), l = t & 63, rg = t >> 6, g = l >> 4, lc = l & 15;
  for (int ch = blockIdx.x; ch < 72; ch += gridDim.x) {
    const int seq = ch >> 2, hh = (ch >> 1) & 1, d = ch & 1;
    const int c0 = seq < 16 ? seq * 16 : 256 + (seq - 16) * 128;
    const int n = seq < 16 ? 16 : 128;
    const int i = rg * 16 + lc;
    floatx4 S[4];
#pragma unroll
    for (int mt = 0; mt < 4; ++mt) S[mt] = floatx4{0.f, 0.f, 0.f, 0.f};
    u32x4 pr[4][2]; floatx4 er[4][4];
#define L2_LOAD(k_, u_) do { const int c_ = d ? c0 + n - 1 - (k_) : c0 + (k_); \
      const float* b_ = pe + (size_t)(c_ * 4 + hh * 2 + d) * 8192; \
      pr[u_][0] = *(const u32x4*)((const char*)b_ + t * 16); pr[u_][1] = *(const u32x4*)((const char*)b_ + 4096 + t * 16); \
      _Pragma("unroll") for (int mt = 0; mt < 4; ++mt) er[u_][mt] = *(const floatx4*)&b_[4096 + i * 64 + 16 * mt + 4 * g]; } while (0)
    L2_LOAD(0, 0); L2_LOAD(1, 1); L2_LOAD(2, 2); L2_LOAD(3, 3);
    for (int k = 0; k < n; k += 4) {
#pragma unroll
      for (int u = 0; u < 4; ++u) {
        const int kk = k + u;
        char* slot = lds + (u & 1) * 8192;
        *(u32x4*)(slot + t * 16) = pr[u][0];
        *(u32x4*)(slot + 4096 + t * 16) = pr[u][1];
        floatx4 E[4];
#pragma unroll
        for (int mt = 0; mt < 4; ++mt) E[mt] = er[u][mt];
        if (kk + 4 < n) L2_LOAD(kk + 4, u);
        __syncthreads();
        const int c = d ? c0 + n - 1 - kk : c0 + kk;
        float* Em = pe + (size_t)(c * 4 + hh * 2 + d) * 8192 + 4096;
        half8 bf[2];
#pragma unroll
        for (int kb = 0; kb < 2; ++kb)
#pragma unroll
          for (int e = 0; e < 8; ++e) bf[kb][e] = (h16)S[2 * kb + (e >> 2)][e & 3];
#pragma unroll
        for (int mt = 0; mt < 4; ++mt) *(floatx4*)&Em[i * 64 + 16 * mt + 4 * g] = S[mt];
#pragma unroll
        for (int mt = 0; mt < 4; ++mt) {
          floatx4 a = E[mt];
#pragma unroll
          for (int kb = 0; kb < 2; ++kb) {
            const half8 af = *(const half8*)(slot + ((mt * 2 + kb) * 64 + l) * 16);
            a = __builtin_amdgcn_mfma_f32_16x16x32_f16(af, bf[kb], a, 0, 0, 0);
          }
          S[mt] = a;
        }
      }
    }
    __syncthreads();
  }
}

DI void ln_phase(const h16* __restrict__ y, const float* __restrict__ gam, const float* __restrict__ bet,
                 h16* __restrict__ x16, float* __restrict__ outf, bool final_, int gw, int nw) {
  const int lane = otid() & 63;
  for (int tok = gw; tok < NTOK; tok += nw) {
    const half8 a = *(const half8*)&y[(size_t)tok * 1024 + lane * 8];
    const half8 b = *(const half8*)&y[(size_t)tok * 1024 + 512 + lane * 8];
    float v[16];
    float s = 0.f;
#pragma unroll
    for (int j = 0; j < 8; ++j) { v[j] = (float)a[j]; v[8 + j] = (float)b[j]; s += v[j] + v[8 + j]; }
    const float mu = wave_sum(s) * (1.f / 1024.f);
    float q = 0.f;
#pragma unroll
    for (int j = 0; j < 16; ++j) { const float dd = v[j] - mu; q += dd * dd; }
    const float rstd = rsqrtf(wave_sum(q) * (1.f / 1024.f) + 1e-5f);
    float o[16];
#pragma unroll
    for (int j = 0; j < 8; ++j) {
      o[j] = (v[j] - mu) * rstd * gam[lane * 8 + j] + bet[lane * 8 + j];
      o[8 + j] = (v[8 + j] - mu) * rstd * gam[512 + lane * 8 + j] + bet[512 + lane * 8 + j];
    }
    if (final_) {
      float* op = outf + (size_t)tok * 1024;
      *(float4*)&op[lane * 8] = float4{o[0], o[1], o[2], o[3]};
      *(float4*)&op[lane * 8 + 4] = float4{o[4], o[5], o[6], o[7]};
      *(float4*)&op[512 + lane * 8] = float4{o[8], o[9], o[10], o[11]};
      *(float4*)&op[512 + lane * 8 + 4] = float4{o[12], o[13], o[14], o[15]};
    } else {
      half8 oa, ob;
#pragma unroll
      for (int j = 0; j < 8; ++j) { oa[j] = (h16)o[j]; ob[j] = (h16)o[8 + j]; }
      *(half8*)&x16[(size_t)tok * 1024 + lane * 8] = oa;
      *(half8*)&x16[(size_t)tok * 1024 + 512 + lane * 8] = ob;
    }
  }
}

#define XB_TMO      128
#define XB_XCNT(j)  (256  + 64 * (j))
#define XB_XSUB(j)  (1280 + 64 * (j))
#define XB_XGEN(j)  (2304 + 64 * (j))
#define XB_TOP      3328
#define XB_TOPGEN   3392
#define XCD_BAR_WORDS 3456
#define XB_SPIN_CAP (1u << 18)
#define LAS __attribute__((address_space(3)))
DI unsigned xb_ld(unsigned* p) { return __hip_atomic_load(p, __ATOMIC_RELAXED, __HIP_MEMORY_SCOPE_AGENT); }
DI unsigned xb_add(unsigned* p, unsigned v) { return __hip_atomic_fetch_add(p, v, __ATOMIC_RELAXED, __HIP_MEMORY_SCOPE_AGENT); }
DI unsigned xb_xcc_id() { return (unsigned)__builtin_amdgcn_s_getreg((3 << 11) | 20) & 0xFu; }
#define XB_SPIN(cond, bar) do { unsigned _sp = 0; while (cond) { __builtin_amdgcn_s_sleep(1); \
    if ((++_sp & 255u) == 0u) { if (xb_ld(&(bar)[XB_TMO])) break; if (_sp > XB_SPIN_CAP) { atomicAdd(&(bar)[XB_TMO], 1u); break; } } } } while (0)
struct XcdBarrier { unsigned* bar; unsigned x; volatile LAS unsigned* st; };
DI XcdBarrier xcd_barrier_post(unsigned* bar, volatile LAS unsigned* st) {
  XcdBarrier b; b.bar = bar; b.x = xb_xcc_id(); b.st = st;
  if (threadIdx.x == 0) (void)xb_add(&bar[XB_XCNT(b.x)], 1u);
  return b;
}
DI void xcd_barrier_complete(unsigned* bar, unsigned x, unsigned& nloc, unsigned& nx) {
  const unsigned G = gridDim.x * gridDim.y * gridDim.z;
  unsigned sum, cnt, mine, sp = 0u;
  for (;;) {
    sum = 0u; cnt = 0u; mine = 0u;
#pragma unroll
    for (unsigned j = 0; j < 16; ++j) { const unsigned c = xb_ld(&bar[XB_XCNT(j)]); sum += c; cnt += (c > 0u) ? 1u : 0u; mine = (j == x) ? c : mine; }
    if (sum == G) break;
    __builtin_amdgcn_s_sleep(1);
    if ((++sp & 255u) == 0u) { if (xb_ld(&bar[XB_TMO])) break; if (sp > XB_SPIN_CAP) { atomicAdd(&bar[XB_TMO], 1u); break; } }
  }
  nloc = mine > 0u ? mine : 1u; nx = cnt > 0u ? cnt : 1u;
}
DI void xcd_barrier(const XcdBarrier& b) {
  asm volatile("s_waitcnt vmcnt(0)" ::: "memory");
  __syncthreads();
  if (threadIdx.x == 0) {
    unsigned* bar = b.bar;
    __builtin_amdgcn_s_waitcnt(0);
    unsigned nloc = b.st[0], nx = b.st[1];
    if (nloc == 0u) { xcd_barrier_complete(bar, b.x, nloc, nx); b.st[0] = nloc; b.st[1] = nx; }
    const unsigned old = xb_add(&bar[XB_XSUB(b.x)], 1u);
    const unsigned gen = old / nloc;
    if (old + 1u == (gen + 1u) * nloc) {
      __builtin_amdgcn_fence(__ATOMIC_RELEASE, "agent");
      asm volatile("s_waitcnt vmcnt(0)" ::: "memory");
      const unsigned og = xb_add(&bar[XB_TOP], 1u);
      const unsigned tg = og / nx;
      if (og + 1u == (tg + 1u) * nx) xb_add(&bar[XB_TOPGEN], 1u);
      else XB_SPIN(xb_ld(&bar[XB_TOPGEN]) == tg, bar);
      __builtin_amdgcn_fence(__ATOMIC_ACQUIRE, "agent");
      xb_add(&bar[XB_XGEN(b.x)], 1u);
      asm volatile("s_waitcnt vmcnt(0)" ::: "memory");
    } else {
      XB_SPIN(xb_ld(&bar[XB_XGEN(b.x)]) == gen, bar);
      __builtin_amdgcn_fence(__ATOMIC_ACQUIRE, "agent");
      asm volatile("s_waitcnt vmcnt(0)" ::: "memory");
    }
  }
  __syncthreads();
}

struct XJob { int x, r, nrank; };
DI XJob xjob_init() { XJob j; j.x = blockIdx.x & 7; j.r = blockIdx.x >> 3; j.nrank = gridDim.x >> 3; return j; }
DI void xjob_map(const XJob& xj, int lj, int MT, int NT, int& mt, int& nt) {
  int mtx;
  if ((NT & 7) == 0) {
    const int p = lj >> 6, q = lj & 63, npn = NT >> 3;
    nt = (p % npn) * 8 + (q & 7);
    mtx = (p / npn) * 8 + (q >> 3);
  } else { mtx = lj / NT; nt = lj % NT; }
  mt = xj.x * (MT >> 3) + mtx;
}

__global__ void __launch_bounds__(256, 2) mega(Params p) {
  cg::grid_group grid = cg::this_grid();
  __shared__ __attribute__((aligned(16))) char smem[40960];
  h16* As = (h16*)smem;
  h16* Bs = (h16*)(smem + 18432);
  const int t = threadIdx.x;
  const int gw = __builtin_amdgcn_readfirstlane((int)(blockIdx.x * 4 + (t >> 6)));
  const int nw = gridDim.x * 4;
  const int gtid = blockIdx.x * 256 + t, gthreads = gridDim.x * 256;
  const int lane = t & 63;
  const XJob xj = xjob_init();

  char* D = (char*)p.out;
  char* W = p.ws;
  h16* x16 = (h16*)(D + D_X16);
  h16* bout = (h16*)(D + D_BOUT);
  h16* lorain = (h16*)(D + D_LORA);
  h16* g16 = (h16*)(D + D_G16);
  h16* Wt = (h16*)(W + W_WT);
  float* sb = (float*)(W + W_SB);
  float* pe = (float*)(W + W_PE);
  float* ybuf = (float*)(W + W_YBUF);
  h16* zpass = (h16*)(W + W_ZPASS);
  h16* zpa = (h16*)(W + W_ZPA);
  h16* zatt = (h16*)(W + W_ZATT);
  h16* pa = (h16*)(W + W_PA);
  h16* aout = (h16*)(W + W_AOUT);
  h16* cout_ = (h16*)(W + W_COUT);
  h16* merged = (h16*)(W + W_MERGED);
  h16* ypre1 = (h16*)(W + W_YPRE1);
  h16* hid = (h16*)(W + W_HID);
  h16* ypre2 = (h16*)(W + W_YPRE2);

  __shared__ u32x4 xb_words;
  if (threadIdx.x == 0) xb_words = u32x4{0u, 0u, 0u, 0u};
  __syncthreads();
  XcdBarrier xb = xcd_barrier_post((unsigned*)(W + W_BAR), (volatile LAS unsigned*)&xb_words);
  grid.sync();
#define SYNC() xcd_barrier(xb)

  if (PH(19)) for (int idx = blockIdx.x * 256 + otid(); idx < NTOK * 128; idx += gthreads) {
    const size_t e = (size_t)idx * 8;
    const float* src = e < (size_t)32768 * 1024 ? p.in[0] + e : p.in[1] + (e - (size_t)32768 * 1024);
    const float4 a = *(const float4*)src, b = *(const float4*)(src + 4);
    half8 o;
    o[0] = (h16)a.x; o[1] = (h16)a.y; o[2] = (h16)a.z; o[3] = (h16)a.w;
    o[4] = (h16)b.x; o[5] = (h16)b.y; o[6] = (h16)b.z; o[7] = (h16)b.w;
    *(half8*)&x16[e] = o;
  }

  for (int L = 0; L < 4; ++L) {
    if (PH(20)) {
      float* tile = (float*)smem;
      tconv(p.in[3] + (size_t)L * 1024 * 6272, Wt + WT_IN, 1024, 6272, tile);
      for (int b = 0; b < 3; ++b)
        tconv(p.in[18] + ((size_t)L * 3 + b) * 512 * 1024, Wt + WT_BR + (size_t)b * 1024 * 512, 512, 1024, tile);
      tconv(p.in[19] + (size_t)L * 1024 * 1024, Wt + WT_O, 1024, 1024, tile);
      tconv(p.in[22] + (size_t)L * 1024 * 4096, Wt + WT_F1, 1024, 4096, tile);
      tconv(p.in[23] + (size_t)L * 4096 * 1024, Wt + WT_F2, 4096, 1024, tile);
      for (int g = 0; g < 4; ++g)
        tconv(p.in[4] + ((size_t)L * 4 + g) * 128 * 128, Wt + WT_POOL + (size_t)g * 128 * 128, 128, 128, tile);
      for (int d = 0; d < 2; ++d) {
        tconv(p.in[8] + ((size_t)L * 2 + d) * 64 * 512, Wt + WT_W2 + (size_t)d * 512 * 64, 64, 512, tile);
        tconv(p.in[10] + ((size_t)L * 2 + d) * 64 * 512, Wt + WT_A2 + (size_t)d * 512 * 64, 64, 512, tile);
      }
      tconv(p.in[11] + (size_t)L * 128 * 512, Wt + WT_G2, 128, 512, tile);
    }
    SYNC();
    const float* mu = p.in[6] + (size_t)L * 1920;

    if (PH(1)) for (int lj = xj.r; lj < 64 * 3; lj += xj.nrank) {
      int mt, nt; xjob_map(xj, lj, 512, 3, mt, nt); const int m0 = mt * 128;
      floatx16 acc[2][2]; acc_zero<2>(acc);
      gemm_core<2>(x16 + (size_t)m0 * 1024, 1024, Wt + WT_IN + (size_t)(2048 + nt * 128) * 1024, 1024, 1024, acc, As, Bs);
      epi_apply<2>(acc, [&](int r, int c, float v) { zpass[(size_t)(m0 + r) * 384 + nt * 128 + c] = (h16)v; });
    }
    SYNC();
    if (PH(2)) for (int idx = blockIdx.x * 256 + otid(); idx < NTOK * 48; idx += gthreads) {
      const int tok = idx / 48, c0 = (idx % 48) * 8;
      int s0, len; seq_of(tok, s0, len);
      const half8 z = *(const half8*)&zpass[(size_t)tok * 384 + c0];
      const bool hp = tok > s0, hn = tok < s0 + len - 1;
      half8 zp = *(const half8*)&zpass[(size_t)(tok - (hp ? 1 : 0)) * 384 + c0];
      half8 zn = *(const half8*)&zpass[(size_t)(tok + (hn ? 1 : 0)) * 384 + c0];
#pragma unroll
      for (int j = 0; j < 8; ++j) { zp[j] = hp ? zp[j] : (h16)0.f; zn[j] = hn ? zn[j] : (h16)0.f; }
      half8 o;
#pragma unroll
      for (int j = 0; j < 8; ++j) {
        const float u0 = (float)z[j];
        const float u = u0 + mu[1536 + c0 + j] * (0.5f * ((float)zp[j] + (float)zn[j]) - u0);
        const float th = 1.f - 2.f * __builtin_amdgcn_rcpf(1.f + __expf(2.f * u));
        const float r = c0 < 128 ? th : (c0 < 256 ? u : sigmoidf_(u));
        o[j] = (h16)r;
      }
      *(half8*)&lorain[(size_t)tok * 384 + c0] = o;
    }
    SYNC();

    for (int ps = 0; ps < 4; ++ps) {
      const int njt = ps == 0 ? 8 : 5;
      if (PH(3)) for (int lj = xj.r; lj < 64 * njt; lj += xj.nrank) {
        const int mt = xj.x * 64 + lj / njt, jt = ps == 0 ? ((lj + (lj >> 6)) & 7) : 3 + lj % 5, m0 = mt * 128;
        floatx16 acc[2][2]; acc_zero<2>(acc);
        if (jt < 3) {
          gemm_core<2>(x16 + (size_t)m0 * 1024, 1024, Wt + WT_IN + (size_t)(512 + jt * 512 + 128 * ps) * 1024, 1024, 1024, acc, As, Bs);
          epi_apply<2>(acc, [&](int r, int c, float v) { zpass[(size_t)(m0 + r) * 384 + jt * 128 + c] = (h16)v; });
        } else if (jt < 5) {
          const int d = jt - 3;
          gemm_core<2>(lorain + (size_t)m0 * 384 + 64 * d, 384, Wt + WT_W2 + (size_t)(d * 512 + 128 * ps) * 64, 64, 64, acc, As, Bs);
          const float* w0 = p.in[7] + ((size_t)L * 2 + d) * 512 + 128 * ps;
          epi_apply<2>(acc, [&](int r, int c, float v) {
            const float x = -(w0[c] + v);
            const float sp = fmaxf(x, 0.f) + __logf(1.f + __expf(-fabsf(x)));
            const float dec = __expf(-__expf(-sp - 0.5f));
            sb[((size_t)(m0 + r) * 2 + (c >> 6)) * 352 + d * 64 + (c & 63)] = dec;
          });
        } else if (jt < 7) {
          const int d = jt - 5;
          gemm_core<2>(lorain + (size_t)m0 * 384 + 128 + 64 * d, 384, Wt + WT_A2 + (size_t)(d * 512 + 128 * ps) * 64, 64, 64, acc, As, Bs);
          const float* a0 = p.in[9] + ((size_t)L * 2 + d) * 512 + 128 * ps;
          epi_apply<2>(acc, [&](int r, int c, float v) {
            ((h16*)(sb + ((size_t)(m0 + r) * 2 + (c >> 6)) * 352 + 128))[192 + 128 * d + (c & 63)] = (h16)sigmoidf_(a0[c] + v);
          });
        } else {
          gemm_core<2>(lorain + (size_t)m0 * 384 + 256, 384, Wt + WT_G2 + (size_t)(128 * ps) * 128, 128, 128, acc, As, Bs);
          epi_apply<2>(acc, [&](int r, int c, float v) { g16[(size_t)(m0 + r) * 128 + c] = (h16)v; });
        }
      }
      SYNC();
      if (PH(4)) {
        const int lane = otid() & 63;
        const float* kk_w = p.in[12] + (size_t)L * 512 + 128 * ps;
        const float* ka_w = p.in[13] + (size_t)L * 512 + 128 * ps;
        float muc[2][3], kkc[2], kac[2];
#pragma unroll
        for (int hh = 0; hh < 2; ++hh) {
          const int cl = 64 * hh + lane;
#pragma unroll
          for (int q = 0; q < 3; ++q) muc[hh][q] = mu[q * 512 + 128 * ps + cl];
          kkc[hh] = kk_w[cl]; kac[hh] = ka_w[cl];
        }
        for (int tb = gw; tb < NTOK; tb += 2 * nw) {
          float z0[2][2][3], zm[2][2][3], zn[2][2][3], af[2][2], ab[2][2];
#pragma unroll
          for (int u = 0; u < 2; ++u) {
            const int tok = tb + u * nw;
            int s0, len; seq_of(tok, s0, len);
            const bool hp = tok > s0, hn = tok < s0 + len - 1;
            const h16* zp = zpass + (size_t)tok * 384;
#pragma unroll
            for (int hh = 0; hh < 2; ++hh) {
              const int cl = 64 * hh + lane;
#pragma unroll
              for (int q = 0; q < 3; ++q) {
                z0[u][hh][q] = (float)zp[q * 128 + cl];
                const float a_ = (float)zp[q * 128 + cl - (hp ? 384 : 0)];
                const float b_ = (float)zp[q * 128 + cl + (hn ? 384 : 0)];
                zm[u][hh][q] = hp ? a_ : 0.f; zn[u][hh][q] = hn ? b_ : 0.f;
              }
              const h16* sp = (const h16*)(sb + ((size_t)tok * 2 + hh) * 352 + 128);
              af[u][hh] = (float)sp[192 + lane]; ab[u][hh] = (float)sp[320 + lane];
            }
          }
#pragma unroll
          for (int u = 0; u < 2; ++u) {
            const int tok = tb + u * nw;
#pragma unroll
            for (int hh = 0; hh < 2; ++hh) {
              float uu[3];
#pragma unroll
              for (int q = 0; q < 3; ++q) uu[q] = z0[u][hh][q] + muc[hh][q] * (0.5f * (zm[u][hh][q] + zn[u][hh][q]) - z0[u][hh][q]);
              const float r = uu[0], k = uu[1], v = uu[2];
              const float kkr = k * kkc[hh];
              const float kk = kkr * __builtin_amdgcn_rsqf(fmaxf(wave_sum(kkr * kkr), 1e-24f));
              h16* sp = (h16*)(sb + ((size_t)tok * 2 + hh) * 352 + 128);
              const float ka = kac[hh], a1 = af[u][hh], a2 = ab[u][hh];
              sp[lane] = (h16)kk; sp[64 + lane] = (h16)r; sp[128 + lane] = (h16)v;
              sp[192 + lane] = (h16)(-kk * a1); sp[256 + lane] = (h16)(k * (1.f + (a1 - 1.f) * ka));
              sp[320 + lane] = (h16)(-kk * a2); sp[384 + lane] = (h16)(k * (1.f + (a2 - 1.f) * ka));
            }
          }
        }
      }
      SYNC();
      if (PH(5)) scan_l13<false>(sb, pe, ybuf, gw, nw);
      SYNC();
      if (PH(6)) {
        if (blockIdx.x < 72) scan_l2(pe, smem);
        else if (ps == 3) {
          const int r2 = (blockIdx.x - 72) >> 3, nr2 = (gridDim.x - 72) >> 3;
          for (int lj = r2; lj < 64 * 6; lj += nr2) {
            const int mt = xj.x * 64 + lj / 6, nt = lj % 6, m0 = mt * 128;
            floatx16 acc[2][2]; acc_zero<2>(acc);
            gemm_core<2>(x16 + (size_t)m0 * 1024, 1024, Wt + WT_IN + (size_t)(2432 + nt * 128) * 1024, 1024, 1024, acc, As, Bs);
            epi_apply<2>(acc, [&](int r, int c, float v) { zatt[(size_t)(m0 + r) * 768 + nt * 128 + c] = (h16)v; });
          }
        } else {
          const int r2 = (blockIdx.x - 72) >> 3, nr2 = (gridDim.x - 72) >> 3;
          for (int lj = r2; lj < 64 * 3; lj += nr2) {
            const int mt = xj.x * 64 + lj / 3, jt = lj % 3, m0 = mt * 128;
            floatx16 acc[2][2]; acc_zero<2>(acc);
            gemm_core<2>(x16 + (size_t)m0 * 1024, 1024, Wt + WT_IN + (size_t)(512 + jt * 512 + 128 * (ps + 1)) * 1024, 1024, 1024, acc, As, Bs);
            epi_apply<2>(acc, [&](int r, int c, float v) { zpass[(size_t)(m0 + r) * 384 + jt * 128 + c] = (h16)v; });
          }
        }
      }
      SYNC();
      if (PH(7)) scan_l13<true>(sb, pe, ybuf, gw, nw);
      SYNC();
      if (PH(8)) {
        const int lane = otid() & 63;
        const float* rk = p.in[14] + (size_t)L * 512 + 128 * ps;
        const float* gng = p.in[15] + (size_t)L * 512 + 128 * ps;
        const float* gnb = p.in[16] + (size_t)L * 512 + 128 * ps;
        float rkc[2], ggc[2], gbc[2];
#pragma unroll
        for (int hh = 0; hh < 2; ++hh) { rkc[hh] = rk[64 * hh + lane]; ggc[hh] = gng[64 * hh + lane]; gbc[hh] = gnb[64 * hh + lane]; }
        for (int tb = gw; tb < NTOK; tb += 2 * nw) {
          float yv[2][2], rr[2][2], vv[2][2], kb_[2][2], gg[2][2];
#pragma unroll
          for (int u = 0; u < 2; ++u) {
            const int tok = tb + u * nw;
#pragma unroll
            for (int hh = 0; hh < 2; ++hh) {
              const int cl = 64 * hh + lane;
              yv[u][hh] = ybuf[(size_t)tok * 128 + cl] + ybuf[((size_t)NTOK + tok) * 128 + cl];
              const h16* sp = (const h16*)(sb + ((size_t)tok * 2 + hh) * 352 + 128);
              rr[u][hh] = (float)sp[64 + lane]; vv[u][hh] = (float)sp[128 + lane];
              kb_[u][hh] = 0.5f * ((float)sp[256 + lane] + (float)sp[384 + lane]);
              gg[u][hh] = (float)g16[(size_t)tok * 128 + cl];
            }
          }
#pragma unroll
          for (int u = 0; u < 2; ++u) {
            const int tok = tb + u * nw;
#pragma unroll
            for (int hh = 0; hh < 2; ++hh) {
              const int cl = 64 * hh + lane;
              const float y = yv[u][hh];
              const float mean = wave_sum(y) * (1.f / 64.f);
              const float dy = y - mean;
              const float var = wave_sum(dy * dy) * (1.f / 64.f);
              const float yn = dy * rsqrtf(var + 64e-5f) * ggc[hh] + gbc[hh];
              const float bs = wave_sum(rr[u][hh] * kb_[u][hh] * rkc[hh]);
              const float o = (yn + bs * vv[u][hh]) * gg[u][hh];
              bout[(size_t)tok * 512 + 128 * ps + cl] = (h16)o;
            }
          }
        }
      }
      SYNC();
    }

    if (PH(9)) for (int lj = xj.r; lj < 64 * 4; lj += xj.nrank) {
      int mt, nt; xjob_map(xj, lj, 512, 4, mt, nt); const int m0 = mt * 128;
      const int wrow = nt * 128;
      floatx16 acc[2][2]; acc_zero<2>(acc);
      gemm_core<2>(x16 + (size_t)m0 * 1024, 1024, Wt + WT_IN + (size_t)wrow * 1024, 1024, 1024, acc, As, Bs);
      epi_apply<2>(acc, [&](int r, int c, float v) { zpa[(size_t)(m0 + r) * 512 + nt * 128 + c] = (h16)v; });
    }
    SYNC();
    if (PH(10)) for (int idx = blockIdx.x * 256 + otid(); idx < NTOK * 64; idx += gthreads) {
      const int tok = idx >> 6, c0 = (idx & 63) * 8;
      int s0, len; seq_of(tok, s0, len);
      const int wd = 2 << (c0 >> 7);
      const int pos = tok - s0;
      const int lo = max(pos - wd / 2, 0), hi = min(pos + wd / 2 - 1, len - 1);
      float sum[8];
#pragma unroll
      for (int j = 0; j < 8; ++j) sum[j] = 0.f;
#pragma unroll
      for (int k = 0; k < 16; ++k) {
        const int tt = lo + k;
        const bool ok = tt <= hi;
        const half8 z = *(const half8*)&zpa[(size_t)(s0 + (ok ? tt : hi)) * 512 + c0];
#pragma unroll
        for (int j = 0; j < 8; ++j) sum[j] += ok ? (float)z[j] : 0.f;
      }
      const half8 zc = *(const half8*)&zpa[(size_t)tok * 512 + c0];
      const float ic = __builtin_amdgcn_rcpf((float)(hi - lo + 1));
      half8 o;
#pragma unroll
      for (int j = 0; j < 8; ++j) o[j] = (h16)(sum[j] * ic - (float)zc[j]);
      *(half8*)&pa[(size_t)tok * 512 + c0] = o;
    }
    if (PH(11)) for (int item = blockIdx.x; item < 4096; item += gridDim.x)
      attn_item(item, zatt, cout_, p.in[2], p.in[17] + (size_t)L * 8, (h16*)smem, (h16*)(smem + 18432), (float*)(smem + 18432 + 17408));
    SYNC();
    if (PH(12)) for (int lj = xj.r; lj < 64 * 4; lj += xj.nrank) {
      int mt, g; xjob_map(xj, lj, 512, 4, mt, g); const int m0 = mt * 128;
      floatx16 acc[2][2]; acc_zero<2>(acc);
      gemm_core<2>(pa + (size_t)m0 * 512 + 128 * g, 512, Wt + WT_POOL + (size_t)g * 128 * 128, 128, 128, acc, As, Bs);
      const float* psc = p.in[5] + (size_t)L * 512 + 128 * g;
      epi_apply<2>(acc, [&](int r, int c, float v) { aout[(size_t)(m0 + r) * 512 + 128 * g + c] = (h16)(v * psc[c]); });
    }
    SYNC();
    if (PH(13)) for (int lj = xj.r; lj < 64 * 16; lj += xj.nrank) {
      int mt, nt; xjob_map(xj, lj, 512, 16, mt, nt); const int m0 = mt * 128, n0 = nt * 64;
      floatx16 mg[2][1]; acc_zero<1>(mg);
      for (int b = 0; b < 3; ++b) {
        floatx16 ag[2][1]; acc_zero<1>(ag);
        gemm_core<1>(x16 + (size_t)m0 * 1024, 1024, Wt + WT_IN + (size_t)(3200 + 1024 * b + n0) * 1024, 1024, 1024, ag, As, Bs);
        floatx16 ap[2][1]; acc_zero<1>(ap);
        const h16* br = b == 0 ? aout : (b == 1 ? bout : cout_);
        gemm_core<1>(br + (size_t)m0 * 512, 512, Wt + WT_BR + (size_t)(b * 1024 + n0) * 512, 512, 512, ap, As, Bs);
#pragma unroll
        for (int i = 0; i < 2; ++i)
#pragma unroll
          for (int r = 0; r < 16; ++r) mg[i][0][r] += sigmoidf_(ag[i][0][r]) * ap[i][0][r];
      }
      epi_apply<1>(mg, [&](int r, int c, float v) { merged[(size_t)(m0 + r) * 1024 + n0 + c] = (h16)v; });
    }
    SYNC();
    if (PH(14)) for (int lj = xj.r; lj < 64 * 8; lj += xj.nrank) {
      int mt, nt; xjob_map(xj, lj, 512, 8, mt, nt); const int m0 = mt * 128, n0 = nt * 128;
      floatx16 acc[2][2]; acc_zero<2>(acc);
      gemm_core<2>(merged + (size_t)m0 * 1024, 1024, Wt + WT_O + (size_t)n0 * 1024, 1024, 1024, acc, As, Bs);
      epi_apply<2>(acc, [&](int r, int c, float v) {
        const size_t o = (size_t)(m0 + r) * 1024 + n0 + c;
        ypre1[o] = (h16)(ALPHA * (float)x16[o] + v);
      });
    }
    SYNC();
    if (PH(15)) ln_phase(ypre1, p.in[20] + (size_t)L * 1024, p.in[21] + (size_t)L * 1024, x16, nullptr, false, gw, nw);
    SYNC();
    for (int hf = 0; hf < 4; ++hf) {
      if (PH(16)) for (int lj = xj.r; lj < 16 * 32; lj += xj.nrank) {
        int mt, nt; xjob_map(xj, lj, 128, 32, mt, nt); const int m0 = mt * 128, n0 = nt * 128;
        floatx16 acc[2][2]; acc_zero<2>(acc);
        gemm_core<2>(x16 + (size_t)(hf * 16384 + m0) * 1024, 1024, Wt + WT_F1 + (size_t)n0 * 1024, 1024, 1024, acc, As, Bs);
        epi_apply<2>(acc, [&](int r, int c, float v) {
          const float u = fmaxf(v, 0.f);
          hid[(size_t)(m0 + r) * 4096 + n0 + c] = (h16)(u * u);
        });
      }
      SYNC();
      if (PH(17)) for (int lj = xj.r; lj < 16 * 8; lj += xj.nrank) {
        int mt, nt; xjob_map(xj, lj, 128, 8, mt, nt); const int m0 = mt * 128, n0 = nt * 128;
        floatx16 acc[2][2]; acc_zero<2>(acc);
        gemm_core<2>(hid + (size_t)m0 * 4096, 4096, Wt + WT_F2 + (size_t)n0 * 4096, 4096, 4096, acc, As, Bs);
        epi_apply<2>(acc, [&](int r, int c, float v) {
          const size_t o = (size_t)(hf * 16384 + m0 + r) * 1024 + n0 + c;
          ypre2[o] = (h16)(ALPHA * (float)x16[o] + v);
        });
      }
      SYNC();
    }
    if (PH(18)) ln_phase(ypre2, p.in[24] + (size_t)L * 1024, p.in[25] + (size_t)L * 1024, x16, p.out, L == 3, gw, nw);
    SYNC();
  }
}

extern "C" void kernel_launch(void* const* d_in, const int* in_sizes, int n_in, void* d_out, int out_size,
                              void* d_ws, size_t ws_size, hipStream_t stream) {
  static int grid_blocks = 0;
  if (!grid_blocks) {
    int dev = 0, cus = 0, per_cu = 0;
    hipGetDevice(&dev);
    hipDeviceGetAttribute(&cus, hipDeviceAttributeMultiprocessorCount, dev);
    hipOccupancyMaxActiveBlocksPerMultiprocessor(&per_cu, mega, 256, 0);
    if (per_cu > 2) per_cu = 2;
    if (per_cu < 1) per_cu = 1;
    grid_blocks = cus * per_cu;
  }
  Params p{};
  for (int i = 0; i < 26; ++i) p.in[i] = (const float*)d_in[i];
  p.out = (float*)d_out;
  p.ws = (char*)d_ws;
  hipMemsetAsync((char*)d_ws + W_BAR, 0, XCD_BAR_WORDS * sizeof(unsigned), stream);
  void* args[] = {&p};
  hipError_t e = hipLaunchCooperativeKernel((void*)mega, dim3(grid_blocks), dim3(256), args, 0, stream);
  if (e != hipSuccess) fprintf(stderr, "cooperative launch failed: %s (grid %d)\n", hipGetErrorString(e), grid_blocks);
}
```

```cpp
#include <hip/hip_runtime.h>
#include <hip/hip_fp16.h>
#include <hip/hip_cooperative_groups.h>
#include <cstdio>
#include <cstdint>
namespace cg = cooperative_groups;

typedef _Float16 h16;
typedef _Float16 half8 __attribute__((ext_vector_type(8)));
typedef _Float16 half4 __attribute__((ext_vector_type(4)));
typedef float floatx16 __attribute__((ext_vector_type(16)));
typedef float floatx4 __attribute__((ext_vector_type(4)));
typedef float float2v __attribute__((ext_vector_type(2)));
typedef unsigned int u32x4 __attribute__((ext_vector_type(4)));
typedef const __attribute__((address_space(4))) float2v* cf2p;

#define DI __device__ __forceinline__
#ifdef ONLY
#define PH(n) (ONLY == (n))
#else
#define PH(n) true
#endif

struct Params {
  const float* in[26];
  float* out;
  char* ws;
};

constexpr int NTOK = 65536;
constexpr size_t MiB = 1ull << 20;
constexpr size_t D_X16 = 0, D_BOUT = 128 * MiB, D_LORA = 192 * MiB, D_G16 = 240 * MiB;
constexpr size_t W_WT = 0;
constexpr size_t W_SB = 36 * MiB, W_PE = 324 * MiB, W_YBUF = 388 * MiB, W_ZPASS = 452 * MiB;
constexpr size_t W_ZPA = 36 * MiB, W_PA = 100 * MiB, W_AOUT = 260 * MiB, W_COUT = 324 * MiB, W_ZATT = 212 * MiB;
constexpr size_t W_MERGED = 36 * MiB, W_YPRE1 = 164 * MiB;
constexpr size_t W_HID = 36 * MiB, W_YPRE2 = 292 * MiB;
constexpr size_t W_BAR = 504 * MiB;
constexpr size_t WT_IN = 0, WT_BR = 6422528, WT_O = 7995392, WT_F1 = 9043968, WT_F2 = 13238272,
                 WT_POOL = 17432576, WT_W2 = 17498112, WT_A2 = 17563648, WT_G2 = 17629184;

constexpr float ALPHA = 1.681792830507429f;

DI void seq_of(int tok, int& s0, int& len) {
  if (tok < 32768) { s0 = tok & ~2047; len = 2048; }
  else { s0 = 32768 + ((tok - 32768) & ~16383); len = 16384; }
}
DI int otid() { int t = threadIdx.x; asm volatile("" : "+v"(t)); return t; }
template <int CTRL> DI float dppf(float v) {
  return __builtin_bit_cast(float, __builtin_amdgcn_mov_dpp(__builtin_bit_cast(int, v), CTRL, 0xf, 0xf, true));
}
DI float wave_sum(float v) {
  v += dppf<0xB1>(v);
  v += dppf<0x4E>(v);
  v += dppf<0x141>(v);
  v += dppf<0x140>(v);
  v += __builtin_bit_cast(float, __builtin_amdgcn_ds_swizzle(__builtin_bit_cast(int, v), 0x401F));
  const float a = __builtin_bit_cast(float, __builtin_amdgcn_readlane(__builtin_bit_cast(int, v), 0));
  const float b = __builtin_bit_cast(float, __builtin_amdgcn_readlane(__builtin_bit_cast(int, v), 32));
  return a + b;
}
DI float sigmoidf_(float x) { return __builtin_amdgcn_rcpf(1.f + __expf(-x)); }
DI float2v fma2(float2v a, float2v b, float2v c) { return __builtin_elementwise_fma(a, b, c); }

DI void tconv(const float* __restrict__ src, h16* __restrict__ dst, int K, int N, float* tile) {
  const int tn = N >> 6, tk = K >> 6, t = otid();
  for (int job = blockIdx.x; job < tk * tn; job += gridDim.x) {
    const int k0 = (job / tn) << 6, n0 = (job % tn) << 6;
    __syncthreads();
#pragma unroll
    for (int i = 0; i < 4; ++i) {
      const int k = (t >> 4) + 16 * i, n4 = (t & 15) * 4;
      const float4 v = *(const float4*)&src[(size_t)(k0 + k) * N + n0 + n4];
      tile[k * 65 + n4 + 0] = v.x; tile[k * 65 + n4 + 1] = v.y;
      tile[k * 65 + n4 + 2] = v.z; tile[k * 65 + n4 + 3] = v.w;
    }
    __syncthreads();
    const int n = t >> 2, ks = (t & 3) * 16;
    half8 o0, o1;
#pragma unroll
    for (int j = 0; j < 8; ++j) {
      o0[j] = (h16)tile[(ks + j) * 65 + n];
      o1[j] = (h16)tile[(ks + 8 + j) * 65 + n];
    }
    *(half8*)&dst[(size_t)(n0 + n) * K + k0 + ks] = o0;
    *(half8*)&dst[(size_t)(n0 + n) * K + k0 + ks + 8] = o1;
  }
}

template <int NJ>
DI void gemm_core(const h16* __restrict__ A, int lda, const h16* __restrict__ Bt, int ldb, int K,
                  floatx16 (&acc)[2][NJ], h16* As, h16* Bs) {
  const int t = otid(), l = t & 63, w = t >> 6, wm = w >> 1, wn = w & 1, h = l >> 5, lr = l & 31;
  u32x4 ra0[4], rb0[2 * NJ], ra1[4], rb1[2 * NJ];
  const h16* Ap = A + (size_t)(t >> 3) * lda + (t & 7) * 8;
  const h16* Bp = Bt + (size_t)(t >> 3) * ldb + (t & 7) * 8;
  const size_t sa = (size_t)32 * lda, sbb = (size_t)32 * ldb;
#define G_LOAD(RA, RB, k_) do { \
    _Pragma("unroll") for (int i = 0; i < 4; ++i) RA[i] = *(const u32x4*)&Ap[i * sa + (k_)]; \
    _Pragma("unroll") for (int i = 0; i < 2 * NJ; ++i) RB[i] = *(const u32x4*)&Bp[i * sbb + (k_)]; } while (0)
#define G_STEP(RA, RB, kn_) do { \
    __syncthreads(); \
    _Pragma("unroll") for (int i = 0; i < 4; ++i) *(u32x4*)&As[((t >> 3) + 32 * i) * 72 + (t & 7) * 8] = RA[i]; \
    _Pragma("unroll") for (int i = 0; i < 2 * NJ; ++i) *(u32x4*)&Bs[((t >> 3) + 32 * i) * 72 + (t & 7) * 8] = RB[i]; \
    __syncthreads(); \
    if ((kn_) < K) G_LOAD(RA, RB, kn_); \
    { half8 a[2][2], b[2][NJ]; \
      _Pragma("unroll") for (int i = 0; i < 2; ++i) a[0][i] = *(const half8*)&As[(wm * 64 + i * 32 + lr) * 72 + h * 8]; \
      _Pragma("unroll") for (int j = 0; j < NJ; ++j) b[0][j] = *(const half8*)&Bs[(wn * 32 * NJ + j * 32 + lr) * 72 + h * 8]; \
      _Pragma("unroll") for (int s = 0; s < 4; ++s) { \
        if (s < 3) { \
          _Pragma("unroll") for (int i = 0; i < 2; ++i) a[(s + 1) & 1][i] = *(const half8*)&As[(wm * 64 + i * 32 + lr) * 72 + (s + 1) * 16 + h * 8]; \
          _Pragma("unroll") for (int j = 0; j < NJ; ++j) b[(s + 1) & 1][j] = *(const half8*)&Bs[(wn * 32 * NJ + j * 32 + lr) * 72 + (s + 1) * 16 + h * 8]; \
        } \
        __builtin_amdgcn_sched_barrier(0); \
        _Pragma("unroll") for (int i = 0; i < 2; ++i) \
          _Pragma("unroll") for (int j = 0; j < NJ; ++j) \
            acc[i][j] = __builtin_amdgcn_mfma_f32_32x32x16_f16(a[s & 1][i], b[s & 1][j], acc[i][j], 0, 0, 0); \
        __builtin_amdgcn_sched_barrier(0); \
      } } } while (0)
  G_LOAD(ra0, rb0, 0);
  if (64 < K) G_LOAD(ra1, rb1, 64);
  for (int k0 = 0; k0 < K; k0 += 128) {
    G_STEP(ra0, rb0, k0 + 128);
    if (k0 + 64 < K) G_STEP(ra1, rb1, k0 + 192);
  }
#undef G_LOAD
#undef G_STEP
}
template <int NJ>
DI void acc_zero(floatx16 (&acc)[2][NJ]) {
#pragma unroll
  for (int i = 0; i < 2; ++i)
#pragma unroll
    for (int j = 0; j < NJ; ++j)
#pragma unroll
      for (int r = 0; r < 16; ++r) acc[i][j][r] = 0.f;
}
template <int NJ>
DI void acc_init_resid(floatx16 (&acc)[2][NJ], const h16* __restrict__ src, size_t ld) {
  const int t = otid(), l = t & 63, w = t >> 6, wm = w >> 1, wn = w & 1, h = l >> 5, lr = l & 31;
#pragma unroll
  for (int i = 0; i < 2; ++i)
#pragma unroll
    for (int j = 0; j < NJ; ++j) {
      const h16* b = src + (size_t)(wm * 64 + i * 32 + 4 * h) * ld + wn * 32 * NJ + j * 32 + lr;
#pragma unroll
      for (int r = 0; r < 16; ++r) acc[i][j][r] = ALPHA * (float)b[(size_t)((r & 3) + 8 * (r >> 2)) * ld];
    }
}
template <int NJ, class F>
DI void epi_apply(const floatx16 (&acc)[2][NJ], F f) {
  const int t = otid(), l = t & 63, w = t >> 6, wm = w >> 1, wn = w & 1, h = l >> 5, lr = l & 31;
#pragma unroll
  for (int i = 0; i < 2; ++i)
#pragma unroll
    for (int j = 0; j < NJ; ++j)
#pragma unroll
      for (int r = 0; r < 16; ++r) {
        f(wm * 64 + i * 32 + (r & 3) + 8 * (r >> 2) + 4 * h, wn * 32 * NJ + j * 32 + lr, acc[i][j][r]);
        if ((r & 3) == 3) __builtin_amdgcn_sched_barrier(0);
      }
}

DI void attn_item(int item, const h16* __restrict__ zpa, h16* __restrict__ cout, const float* __restrict__ rel_bias,
                  const float* __restrict__ sink_l, h16* Ks, h16* Vt, float* bt) {
  const int t = otid(), l = t & 63, w = t >> 6, h = l >> 5, lr = l & 31;
  const int hq = item & 7, qb = item >> 3;
  const int tok0 = qb * 128;
  int s0, len; seq_of(tok0, s0, len);
  const int nb = (tok0 - s0) >> 7, nblk = len >> 7;
  const int kvh = hq >> 2;
  __syncthreads();
  for (int r = t; r < 257; r += 256) {
    const int rel = r - 128;
    const int n = rel < 0 ? -rel : rel;
    int bk = n < 8 ? n : 8 + (n >= 12) + (n >= 16) + (n >= 23) + (n >= 32) + (n >= 46) + (n >= 64) + (n >= 91);
    if (rel > 0) bk += 16;
    bt[r] = rel_bias[bk * 8 + hq];
  }
  const int ql = w * 32 + lr;
  const int qtok = tok0 + ql;
  half8 qf[4];
#pragma unroll
  for (int ds = 0; ds < 4; ++ds) qf[ds] = *(const half8*)&zpa[(size_t)qtok * 768 + hq * 64 + ds * 16 + h * 8];
  float m = sink_l[hq], lsum = 1.f;
  floatx16 O[2];
#pragma unroll
  for (int dt = 0; dt < 2; ++dt)
#pragma unroll
    for (int r = 0; r < 16; ++r) O[dt][r] = 0.f;
  for (int kb = 0; kb < 3; ++kb) {
    const int kblk = nb - 1 + kb;
    if (kblk < 0 || kblk >= nblk) continue;
    const int ktok0 = s0 + kblk * 128;
    __syncthreads();
#pragma unroll
    for (int i = 0; i < 4; ++i) {
      const int c = t + 256 * i, key = c >> 3, seg = c & 7;
      const u32x4 kv = *(const u32x4*)&zpa[(size_t)(ktok0 + key) * 768 + 512 + kvh * 64 + seg * 8];
      *(u32x4*)&Ks[key * 72 + seg * 8] = kv;
      const half8 vv = *(const half8*)&zpa[(size_t)(ktok0 + key) * 768 + 640 + kvh * 64 + seg * 8];
      const int kl = key & 31;
      const int pos = (key & ~31) + (kl & 16) + ((kl >> 2) & 1) * 8 + ((kl >> 3) & 1) * 4 + (kl & 3);
#pragma unroll
      for (int e = 0; e < 8; ++e) Vt[(seg * 8 + e) * 136 + pos] = vv[e];
    }
    __syncthreads();
    floatx16 sc[4];
#pragma unroll
    for (int kt = 0; kt < 4; ++kt) {
#pragma unroll
      for (int r = 0; r < 16; ++r) sc[kt][r] = 0.f;
#pragma unroll
      for (int ds = 0; ds < 4; ++ds) {
        const half8 kf = *(const half8*)&Ks[(kt * 32 + lr) * 72 + ds * 16 + h * 8];
        sc[kt] = __builtin_amdgcn_mfma_f32_32x32x16_f16(kf, qf[ds], sc[kt], 0, 0, 0);
      }
    }
    float bmax = -1e30f;
#pragma unroll
    for (int kt = 0; kt < 4; ++kt)
#pragma unroll
      for (int r = 0; r < 16; ++r) {
        const int keyl = kt * 32 + (r & 3) + 8 * (r >> 2) + 4 * h;
        const int rel = (kb - 1) * 128 + keyl - ql;
        const bool ok = (rel >= -128) && (rel <= 128);
        const int ri = ok ? rel + 128 : 128;
        const float sv = ok ? sc[kt][r] * 0.125f + bt[ri] : -1e30f;
        sc[kt][r] = sv;
        bmax = fmaxf(bmax, sv);
      }
    bmax = fmaxf(bmax, __shfl_xor(bmax, 32));
    const float mnew = fmaxf(m, bmax);
    const float scale = __expf(m - mnew);
    float psum = 0.f;
#pragma unroll
    for (int kt = 0; kt < 4; ++kt)
#pragma unroll
      for (int r = 0; r < 16; ++r) {
        const float pv = __expf(sc[kt][r] - mnew);
        sc[kt][r] = pv;
        psum += pv;
      }
    psum += __shfl_xor(psum, 32);
    lsum = lsum * scale + psum;
    m = mnew;
#pragma unroll
    for (int dt = 0; dt < 2; ++dt)
#pragma unroll
      for (int r = 0; r < 16; ++r) O[dt][r] *= scale;
#pragma unroll
    for (int kt = 0; kt < 4; ++kt)
#pragma unroll
      for (int s = 0; s < 2; ++s) {
        half8 pf;
#pragma unroll
        for (int j = 0; j < 8; ++j) pf[j] = (h16)sc[kt][8 * s + j];
#pragma unroll
        for (int dt = 0; dt < 2; ++dt) {
          const half8 vf = *(const half8*)&Vt[(dt * 32 + lr) * 136 + kt * 32 + s * 16 + h * 8];
          O[dt] = __builtin_amdgcn_mfma_f32_32x32x16_f16(vf, pf, O[dt], 0, 0, 0);
        }
      }
  }
  const float inv = 1.f / lsum;
#pragma unroll
  for (int dt = 0; dt < 2; ++dt)
#pragma unroll
    for (int g = 0; g < 4; ++g) {
      half4 o;
#pragma unroll
      for (int e = 0; e < 4; ++e) o[e] = (h16)(O[dt][4 * g + e] * inv);
      *(half4*)&cout[(size_t)qtok * 512 + hq * 64 + dt * 32 + 8 * g + 4 * h] = o;
    }
}

template <int N> DI void fmac_bc(float& acc, float vec, float s) {
  asm("v_fmac_f32_dpp %0, %1, %2 row_newbcast:%3 row_mask:0xf bank_mask:0xf" : "+v"(acc) : "v"(vec), "v"(s), "i"(N));
}
template <int N> DI float mul_bc(float vec, float s) {
  float r;
  asm("v_mul_f32_dpp %0, %1, %2 row_newbcast:%3 row_mask:0xf bank_mask:0xf" : "=v"(r) : "v"(vec), "v"(s), "i"(N));
  return r;
}
struct ScanIn { floatx4 kk, w, nb, kd, r; float vi; };
struct ScanRaw { half4 kk, nb, kd, r; floatx4 w; h16 vi; };
DI floatx4 h4f(half4 v) { return floatx4{(float)v[0], (float)v[1], (float)v[2], (float)v[3]}; }
DI void pin4(floatx4& v) {
  float a = v[0], b = v[1], c = v[2], d = v[3];
  asm volatile("" : "+v"(a), "+v"(b), "+v"(c), "+v"(d));
  v = floatx4{a, b, c, d};
}
template <int MODE>
DI ScanRaw scan_ld(const float* __restrict__ sb, int c, int hh, int d, int s, unsigned o, unsigned lane) {
  const int tok = c * 128 + (d ? 127 - s : s);
  const float* p = sb + ((size_t)tok * 2 + hh) * 352;
  const h16* ph = (const h16*)(p + 128);
  const h16* pdh = ph + d * 128;
  ScanRaw in;
  in.kk = *(const half4*)&ph[o];
  in.w = *(const floatx4*)&p[d * 64 + o];
  in.nb = *(const half4*)&pdh[192 + o];
  if (MODE != 1) { in.kd = *(const half4*)&pdh[256 + o]; in.vi = ph[128 + lane]; }
  if (MODE == 2) in.r = *(const half4*)&ph[64 + o];
  return in;
}
#define SCAN_R4(M, b) M(b) M(b + 1) M(b + 2) M(b + 3)
#define SCAN_R16(M, b) SCAN_R4(M, b) SCAN_R4(M, b + 4) SCAN_R4(M, b + 8) SCAN_R4(M, b + 12)
#define SCAN_R64(M) SCAN_R16(M, 0) SCAN_R16(M, 16) SCAN_R16(M, 32) SCAN_R16(M, 48)
template <int MODE>
DI float scan_step(float (&S)[64], const ScanRaw& raw) {
  ScanIn in;
  in.kk = h4f(raw.kk); in.w = raw.w; in.nb = h4f(raw.nb);
  if (MODE != 1) { in.kd = h4f(raw.kd); in.vi = (float)raw.vi; }
  if (MODE == 2) in.r = h4f(raw.r);
  pin4(in.kk); pin4(in.w); pin4(in.nb);
  if (MODE != 1) { pin4(in.kd); asm volatile("" : "+v"(in.vi)); }
  if (MODE == 2) pin4(in.r);
  __builtin_amdgcn_sched_barrier(0);
  asm volatile("s_nop 4");
  float dd[8], yy[8];
#pragma unroll
  for (int k = 0; k < 8; ++k) { dd[k] = 0.f; yy[k] = 0.f; }
#define SC_DOT(j) fmac_bc<((j) >> 2)>(dd[(j) & 7], in.kk[(j) & 3], S[j]);
  SCAN_R64(SC_DOT)
  const float dot = ((dd[0] + dd[1]) + (dd[2] + dd[3])) + ((dd[4] + dd[5]) + (dd[6] + dd[7]));
#define SC_U1(b, k) t_[k] = mul_bc<(((b) + (k)) >> 2)>(in.nb[((b) + (k)) & 3], dot);
#define SC_U2(b, k) if (MODE != 1) fmac_bc<(((b) + (k)) >> 2)>(t_[k], in.kd[((b) + (k)) & 3], in.vi);
#define SC_U3(b, k) fmac_bc<(((b) + (k)) >> 2)>(t_[k], in.w[((b) + (k)) & 3], S[(b) + (k)]); S[(b) + (k)] = t_[k];
#define SC_U4(b, k) if (MODE == 2) fmac_bc<(((b) + (k)) >> 2)>(yy[k], in.r[((b) + (k)) & 3], t_[k]);
#define SC_A8(M, b) M(b, 0) M(b, 1) M(b, 2) M(b, 3) M(b, 4) M(b, 5) M(b, 6) M(b, 7)
#define SC_G(b) { float t_[8]; SC_A8(SC_U1, b) SC_A8(SC_U2, b) SC_A8(SC_U3, b) SC_A8(SC_U4, b) }
  SC_G(0) SC_G(8) SC_G(16) SC_G(24) SC_G(32) SC_G(40) SC_G(48) SC_G(56)
  __builtin_amdgcn_sched_barrier(0);
  return ((yy[0] + yy[1]) + (yy[2] + yy[3])) + ((yy[4] + yy[5]) + (yy[6] + yy[7]));
}
template <int MODE>
DI void scan_item(const float* __restrict__ sb, float* __restrict__ pe, float* __restrict__ ybuf, int item, int lane) {
  const int c = item >> 2, hh = (item >> 1) & 1, d = item & 1;
  float S[64];
  float* pbase = pe + (size_t)item * 8192;
  if (MODE == 2) {
#pragma unroll
    for (int j = 0; j < 16; ++j) {
      const floatx4 v = *(const floatx4*)&pbase[4096 + lane * 64 + 4 * j];
      S[4 * j] = v[0]; S[4 * j + 1] = v[1]; S[4 * j + 2] = v[2]; S[4 * j + 3] = v[3];
    }
  } else {
#pragma unroll
    for (int j = 0; j < 64; ++j) S[j] = (MODE == 1 && j == lane) ? 1.f : 0.f;
  }
  float* yout = ybuf + (size_t)d * NTOK * 128 + hh * 64 + lane;
  const unsigned o = 4u * (lane & 15), ul = lane;
  ScanRaw r0 = scan_ld<MODE>(sb, c, hh, d, 0, o, ul), r1 = scan_ld<MODE>(sb, c, hh, d, 1, o, ul), r2 = scan_ld<MODE>(sb, c, hh, d, 2, o, ul);
  for (int s = 0; s < 128; s += 4) {
    ScanRaw r3 = scan_ld<MODE>(sb, c, hh, d, s + 3, o, ul);
    float y = scan_step<MODE>(S, r0);
    if (MODE == 2) yout[(size_t)(c * 128 + (d ? 127 - s : s)) * 128] = y;
    r0 = scan_ld<MODE>(sb, c, hh, d, min(s + 4, 127), o, ul);
    y = scan_step<MODE>(S, r1);
    if (MODE == 2) yout[(size_t)(c * 128 + (d ? 126 - s : s + 1)) * 128] = y;
    r1 = scan_ld<MODE>(sb, c, hh, d, min(s + 5, 127), o, ul);
    y = scan_step<MODE>(S, r2);
    if (MODE == 2) yout[(size_t)(c * 128 + (d ? 125 - s : s + 2)) * 128] = y;
    r2 = scan_ld<MODE>(sb, c, hh, d, min(s + 6, 127), o, ul);
    y = scan_step<MODE>(S, r3);
    if (MODE == 2) yout[(size_t)(c * 128 + (d ? 124 - s : s + 3)) * 128] = y;
  }
  if (MODE == 0) {
    float* o = pbase + 4096 + lane * 64;
#pragma unroll
    for (int j = 0; j < 16; ++j) *(floatx4*)&o[4 * j] = floatx4{S[4 * j], S[4 * j + 1], S[4 * j + 2], S[4 * j + 3]};
  }
  if (MODE == 1) {
    h16* pf = (h16*)pbase + (((lane >> 5) * 64 + ((lane >> 2) & 3) * 16) * 8 + 4 * ((lane >> 4) & 1) + (lane & 3));
#pragma unroll
    for (int j = 0; j < 64; ++j) pf[(j >> 4) * 1024 + (j & 15) * 8] = (h16)S[j];
  }
}
template <bool L3>
DI void scan_l13(const float* __restrict__ sb, float* __restrict__ pe, float* __restrict__ ybuf, int gw, int nw) {
  const int lane = otid() & 63;
  if (L3) {
    for (int item = gw; item < 2048; item += nw) scan_item<2>(sb, pe, ybuf, item, lane);
  } else {
    for (int it = gw; it < 2048; it += nw) scan_item<0>(sb, pe, ybuf, it, lane);
    for (int it = gw; it < 2048; it += nw) scan_item<1>(sb, pe, ybuf, it, lane);
  }
}

DI void scan_l2(float* __restrict__ pe, char* lds) {
  const int t = otid(), l = t & 63, rg = t >> 6, g = l >> 4, lc = l & 15;
  for (int ch = blockIdx.x; ch < 72; ch += gridDim.x) {
    const int seq = ch >> 2, hh = (ch >> 1) & 1, d = ch & 1;
    const int c0 = seq < 16 ? seq * 16 : 256 + (seq - 16) * 128;
    const int n = seq < 16 ? 16 : 128;
    const int i = rg * 16 + lc;
    floatx4 S[4];
#pragma unroll
    for (int mt = 0; mt < 4; ++mt) S[mt] = floatx4{0.f, 0.f, 0.f, 0.f};
    u32x4 pr[4][2]; floatx4 er[4][4];
#define L2_LOAD(k_, u_) do { const int c_ = d ? c0 + n - 1 - (k_) : c0 + (k_); \
      const float* b_ = pe + (size_t)(c_ * 4 + hh * 2 + d) * 8192; \
      pr[u_][0] = *(const u32x4*)((const char*)b_ + t * 16); pr[u_][1] = *(const u32x4*)((const char*)b_ + 4096 + t * 16); \
      _Pragma("unroll") for (int mt = 0; mt < 4; ++mt) er[u_][mt] = *(const floatx4*)&b_[4096 + i * 64 + 16 * mt + 4 * g]; } while (0)
    L2_LOAD(0, 0); L2_LOAD(1, 1); L2_LOAD(2, 2); L2_LOAD(3, 3);
    for (int k = 0; k < n; k += 4) {
#pragma unroll
      for (int u = 0; u < 4; ++u) {
        const int kk = k + u;
        char* slot = lds + (u & 1) * 8192;
        *(u32x4*)(slot + t * 16) = pr[u][0];
        *(u32x4*)(slot + 4096 + t * 16) = pr[u][1];
        floatx4 E[4];
#pragma unroll
        for (int mt = 0; mt < 4; ++mt) E[mt] = er[u][mt];
        if (kk + 4 < n) L2_LOAD(kk + 4, u);
        __syncthreads();
        const int c = d ? c0 + n - 1 - kk : c0 + kk;
        float* Em = pe + (size_t)(c * 4 + hh * 2 + d) * 8192 + 4096;
        half8 bf[2];
#pragma unroll
        for (int kb = 0; kb < 2; ++kb)
#pragma unroll
          for (int e = 0; e < 8; ++e) bf[kb][e] = (h16)S[2 * kb + (e >> 2)][e & 3];
#pragma unroll
        for (int mt = 0; mt < 4; ++mt) *(floatx4*)&Em[i * 64 + 16 * mt + 4 * g] = S[mt];
#pragma unroll
        for (int mt = 0; mt < 4; ++mt) {
          floatx4 a = E[mt];
#pragma unroll
          for (int kb = 0; kb < 2; ++kb) {
            const half8 af = *(const half8*)(slot + ((mt * 2 + kb) * 64 + l) * 16);
            a = __builtin_amdgcn_mfma_f32_16x16x32_f16(af, bf[kb], a, 0, 0, 0);
          }
          S[mt] = a;
        }
      }
    }
    __syncthreads();
  }
}

DI void ln_phase(const h16* __restrict__ y, const float* __restrict__ gam, const float* __restrict__ bet,
                 h16* __restrict__ x16, float* __restrict__ outf, bool final_, int gw, int nw) {
  const int lane = otid() & 63;
  for (int tok = gw; tok < NTOK; tok += nw) {
    const half8 a = *(const half8*)&y[(size_t)tok * 1024 + lane * 8];
    const half8 b = *(const half8*)&y[(size_t)tok * 1024 + 512 + lane * 8];
    float v[16];
    float s = 0.f;
#pragma unroll
    for (int j = 0; j < 8; ++j) { v[j] = (float)a[j]; v[8 + j] = (float)b[j]; s += v[j] + v[8 + j]; }
    const float mu = wave_sum(s) * (1.f / 1024.f);
    float q = 0.f;
#pragma unroll
    for (int j = 0; j < 16; ++j) { const float dd = v[j] - mu; q += dd * dd; }
    const float rstd = rsqrtf(wave_sum(q) * (1.f / 1024.f) + 1e-5f);
    float o[16];
#pragma unroll
    for (int j = 0; j < 8; ++j) {
      o[j] = (v[j] - mu) * rstd * gam[lane * 8 + j] + bet[lane * 8 + j];
      o[8 + j] = (v[8 + j] - mu) * rstd * gam[512 + lane * 8 + j] + bet[512 + lane * 8 + j];
    }
    if (final_) {
      float* op = outf + (size_t)tok * 1024;
      *(float4*)&op[lane * 8] = float4{o[0], o[1], o[2], o[3]};
      *(float4*)&op[lane * 8 + 4] = float4{o[4], o[5], o[6], o[7]};
      *(float4*)&op[512 + lane * 8] = float4{o[8], o[9], o[10], o[11]};
      *(float4*)&op[512 + lane * 8 + 4] = float4{o[12], o[13], o[14], o[15]};
    } else {
      half8 oa, ob;
#pragma unroll
      for (int j = 0; j < 8; ++j) { oa[j] = (h16)o[j]; ob[j] = (h16)o[8 + j]; }
      *(half8*)&x16[(size_t)tok * 1024 + lane * 8] = oa;
      *(half8*)&x16[(size_t)tok * 1024 + 512 + lane * 8] = ob;
    }
  }
}

#define XB_TMO      128
#define XB_XCNT(j)  (256  + 64 * (j))
#define XB_XSUB(j)  (1280 + 64 * (j))
#define XB_XGEN(j)  (2304 + 64 * (j))
#define XB_TOP      3328
#define XB_TOPGEN   3392
#define XCD_BAR_WORDS 3456
#define XB_SPIN_CAP (1u << 18)
#define LAS __attribute__((address_space(3)))
DI unsigned xb_ld(unsigned* p) { return __hip_atomic_load(p, __ATOMIC_RELAXED, __HIP_MEMORY_SCOPE_AGENT); }
DI unsigned xb_add(unsigned* p, unsigned v) { return __hip_atomic_fetch_add(p, v, __ATOMIC_RELAXED, __HIP_MEMORY_SCOPE_AGENT); }
DI unsigned xb_xcc_id() { return (unsigned)__builtin_amdgcn_s_getreg((3 << 11) | 20) & 0xFu; }
#define XB_SPIN(cond, bar) do { unsigned _sp = 0; while (cond) { __builtin_amdgcn_s_sleep(1); \
    if ((++_sp & 255u) == 0u) { if (xb_ld(&(bar)[XB_TMO])) break; if (_sp > XB_SPIN_CAP) { atomicAdd(&(bar)[XB_TMO], 1u); break; } } } } while (0)
struct XcdBarrier { unsigned* bar; unsigned x; volatile LAS unsigned* st; };
DI XcdBarrier xcd_barrier_post(unsigned* bar, volatile LAS unsigned* st) {
  XcdBarrier b; b.bar = bar; b.x = xb_xcc_id(); b.st = st;
  if (threadIdx.x == 0) (void)xb_add(&bar[XB_XCNT(b.x)], 1u);
  return b;
}
DI void xcd_barrier_complete(unsigned* bar, unsigned x, unsigned& nloc, unsigned& nx) {
  const unsigned G = gridDim.x * gridDim.y * gridDim.z;
  unsigned sum, cnt, mine, sp = 0u;
  for (;;) {
    sum = 0u; cnt = 0u; mine = 0u;
#pragma unroll
    for (unsigned j = 0; j < 16; ++j) { const unsigned c = xb_ld(&bar[XB_XCNT(j)]); sum += c; cnt += (c > 0u) ? 1u : 0u; mine = (j == x) ? c : mine; }
    if (sum == G) break;
    __builtin_amdgcn_s_sleep(1);
    if ((++sp & 255u) == 0u) { if (xb_ld(&bar[XB_TMO])) break; if (sp > XB_SPIN_CAP) { atomicAdd(&bar[XB_TMO], 1u); break; } }
  }
  nloc = mine > 0u ? mine : 1u; nx = cnt > 0u ? cnt : 1u;
}
DI void xcd_barrier(const XcdBarrier& b) {
  asm volatile("s_waitcnt vmcnt(0)" ::: "memory");
  __syncthreads();
  if (threadIdx.x == 0) {
    unsigned* bar = b.bar;
    __builtin_amdgcn_s_waitcnt(0);
    unsigned nloc = b.st[0], nx = b.st[1];
    if (nloc == 0u) { xcd_barrier_complete(bar, b.x, nloc, nx); b.st[0] = nloc; b.st[1] = nx; }
    const unsigned old = xb_add(&bar[XB_XSUB(b.x)], 1u);
    const unsigned gen = old / nloc;
    if (old + 1u == (gen + 1u) * nloc) {
      __builtin_amdgcn_fence(__ATOMIC_RELEASE, "agent");
      asm volatile("s_waitcnt vmcnt(0)" ::: "memory");
      const unsigned og = xb_add(&bar[XB_TOP], 1u);
      const unsigned tg = og / nx;
      if (og + 1u == (tg + 1u) * nx) xb_add(&bar[XB_TOPGEN], 1u);
      else XB_SPIN(xb_ld(&bar[XB_TOPGEN]) == tg, bar);
      __builtin_amdgcn_fence(__ATOMIC_ACQUIRE, "agent");
      xb_add(&bar[XB_XGEN(b.x)], 1u);
      asm volatile("s_waitcnt vmcnt(0)" ::: "memory");
    } else {
      XB_SPIN(xb_ld(&bar[XB_XGEN(b.x)]) == gen, bar);
      __builtin_amdgcn_fence(__ATOMIC_ACQUIRE, "agent");
      asm volatile("s_waitcnt vmcnt(0)" ::: "memory");
    }
  }
  __syncthreads();
}

struct XJob { int x, r, nrank; };
DI XJob xjob_init() { XJob j; j.x = blockIdx.x & 7; j.r = blockIdx.x >> 3; j.nrank = gridDim.x >> 3; return j; }
DI void xjob_map(const XJob& xj, int lj, int MT, int NT, int& mt, int& nt) {
  int mtx;
  if ((NT & 7) == 0) {
    const int p = lj >> 6, q = lj & 63, npn = NT >> 3;
    nt = (p % npn) * 8 + (q & 7);
    mtx = (p / npn) * 8 + (q >> 3);
  } else { mtx = lj / NT; nt = lj % NT; }
  mt = xj.x * (MT >> 3) + mtx;
}

__global__ void __launch_bounds__(256, 2) mega(Params p) {
  cg::grid_group grid = cg::this_grid();
  __shared__ __attribute__((aligned(16))) char smem[40960];
  h16* As = (h16*)smem;
  h16* Bs = (h16*)(smem + 18432);
  const int t = threadIdx.x;
  const int gw = __builtin_amdgcn_readfirstlane((int)(blockIdx.x * 4 + (t >> 6)));
  const int nw = gridDim.x * 4;
  const int gtid = blockIdx.x * 256 + t, gthreads = gridDim.x * 256;
  const int lane = t & 63;
  const XJob xj = xjob_init();

  char* D = (char*)p.out;
  char* W = p.ws;
  h16* x16 = (h16*)(D + D_X16);
  h16* bout = (h16*)(D + D_BOUT);
  h16* lorain = (h16*)(D + D_LORA);
  h16* g16 = (h16*)(D + D_G16);
  h16* Wt = (h16*)(W + W_WT);
  float* sb = (float*)(W + W_SB);
  float* pe = (float*)(W + W_PE);
  float* ybuf = (float*)(W + W_YBUF);
  h16* zpass = (h16*)(W + W_ZPASS);
  h16* zpa = (h16*)(W + W_ZPA);
  h16* zatt = (h16*)(W + W_ZATT);
  h16* pa = (h16*)(W + W_PA);
  h16* aout = (h16*)(W + W_AOUT);
  h16* cout_ = (h16*)(W + W_COUT);
  h16* merged = (h16*)(W + W_MERGED);
  h16* ypre1 = (h16*)(W + W_YPRE1);
  h16* hid = (h16*)(W + W_HID);
  h16* ypre2 = (h16*)(W + W_YPRE2);

  __shared__ u32x4 xb_words;
  if (threadIdx.x == 0) xb_words = u32x4{0u, 0u, 0u, 0u};
  __syncthreads();
  XcdBarrier xb = xcd_barrier_post((unsigned*)(W + W_BAR), (volatile LAS unsigned*)&xb_words);
  grid.sync();
#define SYNC() xcd_barrier(xb)

  if (PH(19)) for (int idx = blockIdx.x * 256 + otid(); idx < NTOK * 128; idx += gthreads) {
    const size_t e = (size_t)idx * 8;
    const float* src = e < (size_t)32768 * 1024 ? p.in[0] + e : p.in[1] + (e - (size_t)32768 * 1024);
    const float4 a = *(const float4*)src, b = *(const float4*)(src + 4);
    half8 o;
    o[0] = (h16)a.x; o[1] = (h16)a.y; o[2] = (h16)a.z; o[3] = (h16)a.w;
    o[4] = (h16)b.x; o[5] = (h16)b.y; o[6] = (h16)b.z; o[7] = (h16)b.w;
    *(half8*)&x16[e] = o;
  }

  for (int L = 0; L < 4; ++L) {
    if (PH(20)) {
      float* tile = (float*)smem;
      tconv(p.in[3] + (size_t)L * 1024 * 6272, Wt + WT_IN, 1024, 6272, tile);
      for (int b = 0; b < 3; ++b)
        tconv(p.in[18] + ((size_t)L * 3 + b) * 512 * 1024, Wt + WT_BR + (size_t)b * 1024 * 512, 512, 1024, tile);
      tconv(p.in[19] + (size_t)L * 1024 * 1024, Wt + WT_O, 1024, 1024, tile);
      tconv(p.in[22] + (size_t)L * 1024 * 4096, Wt + WT_F1, 1024, 4096, tile);
      tconv(p.in[23] + (size_t)L * 4096 * 1024, Wt + WT_F2, 4096, 1024, tile);
      for (int g = 0; g < 4; ++g)
        tconv(p.in[4] + ((size_t)L * 4 + g) * 128 * 128, Wt + WT_POOL + (size_t)g * 128 * 128, 128, 128, tile);
      for (int d = 0; d < 2; ++d) {
        tconv(p.in[8] + ((size_t)L * 2 + d) * 64 * 512, Wt + WT_W2 + (size_t)d * 512 * 64, 64, 512, tile);
        tconv(p.in[10] + ((size_t)L * 2 + d) * 64 * 512, Wt + WT_A2 + (size_t)d * 512 * 64, 64, 512, tile);
      }
      tconv(p.in[11] + (size_t)L * 128 * 512, Wt + WT_G2, 128, 512, tile);
    }
    SYNC();
    const float* mu = p.in[6] + (size_t)L * 1920;

    if (PH(1)) for (int lj = xj.r; lj < 64 * 3; lj += xj.nrank) {
      int mt, nt; xjob_map(xj, lj, 512, 3, mt, nt); const int m0 = mt * 128;
      floatx16 acc[2][2]; acc_zero<2>(acc);
      gemm_core<2>(x16 + (size_t)m0 * 1024, 1024, Wt + WT_IN + (size_t)(2048 + nt * 128) * 1024, 1024, 1024, acc, As, Bs);
      epi_apply<2>(acc, [&](int r, int c, float v) { zpass[(size_t)(m0 + r) * 384 + nt * 128 + c] = (h16)v; });
    }
    SYNC();
    if (PH(2)) for (int idx = blockIdx.x * 256 + otid(); idx < NTOK * 48; idx += gthreads) {
      const int tok = idx / 48, c0 = (idx % 48) * 8;
      int s0, len; seq_of(tok, s0, len);
      const half8 z = *(const half8*)&zpass[(size_t)tok * 384 + c0];
      const bool hp = tok > s0, hn = tok < s0 + len - 1;
      half8 zp = *(const half8*)&zpass[(size_t)(tok - (hp ? 1 : 0)) * 384 + c0];
      half8 zn = *(const half8*)&zpass[(size_t)(tok + (hn ? 1 : 0)) * 384 + c0];
#pragma unroll
      for (int j = 0; j < 8; ++j) { zp[j] = hp ? zp[j] : (h16)0.f; zn[j] = hn ? zn[j] : (h16)0.f; }
      half8 o;
#pragma unroll
      for (int j = 0; j < 8; ++j) {
        const float u0 = (float)z[j];
        const float u = u0 + mu[1536 + c0 + j] * (0.5f * ((float)zp[j] + (float)zn[j]) - u0);
        const float th = 1.f - 2.f * __builtin_amdgcn_rcpf(1.f + __expf(2.f * u));
        const float r = c0 < 128 ? th : (c0 < 256 ? u : sigmoidf_(u));
        o[j] = (h16)r;
      }
      *(half8*)&lorain[(size_t)tok * 384 + c0] = o;
    }
    SYNC();

    for (int ps = 0; ps < 4; ++ps) {
      const int njt = ps == 0 ? 8 : 5;
      if (PH(3)) for (int lj = xj.r; lj < 64 * njt; lj += xj.nrank) {
        const int mt = xj.x * 64 + lj / njt, jt = ps == 0 ? ((lj + (lj >> 6)) & 7) : 3 + lj % 5, m0 = mt * 128;
        floatx16 acc[2][2]; acc_zero<2>(acc);
        if (jt < 3) {
          gemm_core<2>(x16 + (size_t)m0 * 1024, 1024, Wt + WT_IN + (size_t)(512 + jt * 512 + 128 * ps) * 1024, 1024, 1024, acc, As, Bs);
          epi_apply<2>(acc, [&](int r, int c, float v) { zpass[(size_t)(m0 + r) * 384 + jt * 128 + c] = (h16)v; });
        } else if (jt < 5) {
          const int d = jt - 3;
          gemm_core<2>(lorain + (size_t)m0 * 384 + 64 * d, 384, Wt + WT_W2 + (size_t)(d * 512 + 128 * ps) * 64, 64, 64, acc, As, Bs);
          const float* w0 = p.in[7] + ((size_t)L * 2 + d) * 512 + 128 * ps;
          epi_apply<2>(acc, [&](int r, int c, float v) {
            const float x = -(w0[c] + v);
            const float sp = fmaxf(x, 0.f) + __logf(1.f + __expf(-fabsf(x)));
            const float dec = __expf(-__expf(-sp - 0.5f));
            sb[((size_t)(m0 + r) * 2 + (c >> 6)) * 352 + d * 64 + (c & 63)] = dec;
          });
        } else if (jt < 7) {
          const int d = jt - 5;
          gemm_core<2>(lorain + (size_t)m0 * 384 + 128 + 64 * d, 384, Wt + WT_A2 + (size_t)(d * 512 + 128 * ps) * 64, 64, 64, acc, As, Bs);
          const float* a0 = p.in[9] + ((size_t)L * 2 + d) * 512 + 128 * ps;
          epi_apply<2>(acc, [&](int r, int c, float v) {
            ((h16*)(sb + ((size_t)(m0 + r) * 2 + (c >> 6)) * 352 + 128))[192 + 128 * d + (c & 63)] = (h16)sigmoidf_(a0[c] + v);
          });
        } else {
          gemm_core<2>(lorain + (size_t)m0 * 384 + 256, 384, Wt + WT_G2 + (size_t)(128 * ps) * 128, 128, 128, acc, As, Bs);
          epi_apply<2>(acc, [&](int r, int c, float v) { g16[(size_t)(m0 + r) * 128 + c] = (h16)v; });
        }
      }
      SYNC();
      if (PH(4)) {
        const int lane = otid() & 63;
        const float* kk_w = p.in[12] + (size_t)L * 512 + 128 * ps;
        const float* ka_w = p.in[13] + (size_t)L * 512 + 128 * ps;
        float muc[2][3], kkc[2], kac[2];
#pragma unroll
        for (int hh = 0; hh < 2; ++hh) {
          const int cl = 64 * hh + lane;
#pragma unroll
          for (int q = 0; q < 3; ++q) muc[hh][q] = mu[q * 512 + 128 * ps + cl];
          kkc[hh] = kk_w[cl]; kac[hh] = ka_w[cl];
        }
        for (int tb = gw; tb < NTOK; tb += 2 * nw) {
          float z0[2][2][3], zm[2][2][3], zn[2][2][3], af[2][2], ab[2][2];
#pragma unroll
          for (int u = 0; u < 2; ++u) {
            const int tok = tb + u * nw;
            int s0, len; seq_of(tok, s0, len);
            const bool hp = tok > s0, hn = tok < s0 + len - 1;
            const h16* zp = zpass + (size_t)tok * 384;
#pragma unroll
            for (int hh = 0; hh < 2; ++hh) {
              const int cl = 64 * hh + lane;
#pragma unroll
              for (int q = 0; q < 3; ++q) {
                z0[u][hh][q] = (float)zp[q * 128 + cl];
                const float a_ = (float)zp[q * 128 + cl - (hp ? 384 : 0)];
                const float b_ = (float)zp[q * 128 + cl + (hn ? 384 : 0)];
                zm[u][hh][q] = hp ? a_ : 0.f; zn[u][hh][q] = hn ? b_ : 0.f;
              }
              const h16* sp = (const h16*)(sb + ((size_t)tok * 2 + hh) * 352 + 128);
              af[u][hh] = (float)sp[192 + lane]; ab[u][hh] = (float)sp[320 + lane];
            }
          }
#pragma unroll
          for (int u = 0; u < 2; ++u) {
            const int tok = tb + u * nw;
#pragma unroll
            for (int hh = 0; hh < 2; ++hh) {
              float uu[3];
#pragma unroll
              for (int q = 0; q < 3; ++q) uu[q] = z0[u][hh][q] + muc[hh][q] * (0.5f * (zm[u][hh][q] + zn[u][hh][q]) - z0[u][hh][q]);
              const float r = uu[0], k = uu[1], v = uu[2];
              const float kkr = k * kkc[hh];
              const float kk = kkr * __builtin_amdgcn_rsqf(fmaxf(wave_sum(kkr * kkr), 1e-24f));
              h16* sp = (h16*)(sb + ((size_t)tok * 2 + hh) * 352 + 128);
              const float ka = kac[hh], a1 = af[u][hh], a2 = ab[u][hh];
              sp[lane] = (h16)kk; sp[64 + lane] = (h16)r; sp[128 + lane] = (h16)v;
              sp[192 + lane] = (h16)(-kk * a1); sp[256 + lane] = (h16)(k * (1.f + (a1 - 1.f) * ka));
              sp[320 + lane] = (h16)(-kk * a2); sp[384 + lane] = (h16)(k * (1.f + (a2 - 1.f) * ka));
            }
          }
        }
      }
      SYNC();
      if (PH(5)) scan_l13<false>(sb, pe, ybuf, gw, nw);
      SYNC();
      if (PH(6)) {
        if (blockIdx.x < 72) scan_l2(pe, smem);
        else if (ps == 3) {
          const int r2 = (blockIdx.x - 72) >> 3, nr2 = (gridDim.x - 72) >> 3;
          for (int lj = r2; lj < 64 * 6; lj += nr2) {
            const int mt = xj.x * 64 + lj / 6, nt = lj % 6, m0 = mt * 128;
            floatx16 acc[2][2]; acc_zero<2>(acc);
            gemm_core<2>(x16 + (size_t)m0 * 1024, 1024, Wt + WT_IN + (size_t)(2432 + nt * 128) * 1024, 1024, 1024, acc, As, Bs);
            epi_apply<2>(acc, [&](int r, int c, float v) { zatt[(size_t)(m0 + r) * 768 + nt * 128 + c] = (h16)v; });
          }
        } else {
          const int r2 = (blockIdx.x - 72) >> 3, nr2 = (gridDim.x - 72) >> 3;
          for (int lj = r2; lj < 64 * 3; lj += nr2) {
            const int mt = xj.x * 64 + lj / 3, jt = lj % 3, m0 = mt * 128;
            floatx16 acc[2][2]; acc_zero<2>(acc);
            gemm_core<2>(x16 + (size_t)m0 * 1024, 1024, Wt + WT_IN + (size_t)(512 + jt * 512 + 128 * (ps + 1)) * 1024, 1024, 1024, acc, As, Bs);
            epi_apply<2>(acc, [&](int r, int c, float v) { zpass[(size_t)(m0 + r) * 384 + jt * 128 + c] = (h16)v; });
          }
        }
      }
      SYNC();
      if (PH(7)) scan_l13<true>(sb, pe, ybuf, gw, nw);
      SYNC();
      if (PH(8)) {
        const int lane = otid() & 63;
        const float* rk = p.in[14] + (size_t)L * 512 + 128 * ps;
        const float* gng = p.in[15] + (size_t)L * 512 + 128 * ps;
        const float* gnb = p.in[16] + (size_t)L * 512 + 128 * ps;
        float rkc[2], ggc[2], gbc[2];
#pragma unroll
        for (int hh = 0; hh < 2; ++hh) { rkc[hh] = rk[64 * hh + lane]; ggc[hh] = gng[64 * hh + lane]; gbc[hh] = gnb[64 * hh + lane]; }
        for (int tb = gw; tb < NTOK; tb += 2 * nw) {
          float yv[2][2], rr[2][2], vv[2][2], kb_[2][2], gg[2][2];
#pragma unroll
          for (int u = 0; u < 2; ++u) {
            const int tok = tb + u * nw;
#pragma unroll
            for (int hh = 0; hh < 2; ++hh) {
              const int cl = 64 * hh + lane;
              yv[u][hh] = ybuf[(size_t)tok * 128 + cl] + ybuf[((size_t)NTOK + tok) * 128 + cl];
              const h16* sp = (const h16*)(sb + ((size_t)tok * 2 + hh) * 352 + 128);
              rr[u][hh] = (float)sp[64 + lane]; vv[u][hh] = (float)sp[128 + lane];
              kb_[u][hh] = 0.5f * ((float)sp[256 + lane] + (float)sp[384 + lane]);
              gg[u][hh] = (float)g16[(size_t)tok * 128 + cl];
            }
          }
#pragma unroll
          for (int u = 0; u < 2; ++u) {
            const int tok = tb + u * nw;
#pragma unroll
            for (int hh = 0; hh < 2; ++hh) {
              const int cl = 64 * hh + lane;
              const float y = yv[u][hh];
              const float mean = wave_sum(y) * (1.f / 64.f);
              const float dy = y - mean;
              const float var = wave_sum(dy * dy) * (1.f / 64.f);
              const float yn = dy * rsqrtf(var + 64e-5f) * ggc[hh] + gbc[hh];
              const float bs = wave_sum(rr[u][hh] * kb_[u][hh] * rkc[hh]);
              const float o = (yn + bs * vv[u][hh]) * gg[u][hh];
              bout[(size_t)tok * 512 + 128 * ps + cl] = (h16)o;
            }
          }
        }
      }
      SYNC();
    }

    if (PH(9)) for (int lj = xj.r; lj < 64 * 4; lj += xj.nrank) {
      int mt, nt; xjob_map(xj, lj, 512, 4, mt, nt); const int m0 = mt * 128;
      const int wrow = nt * 128;
      floatx16 acc[2][2]; acc_zero<2>(acc);
      gemm_core<2>(x16 + (size_t)m0 * 1024, 1024, Wt + WT_IN + (size_t)wrow * 1024, 1024, 1024, acc, As, Bs);
      epi_apply<2>(acc, [&](int r, int c, float v) { zpa[(size_t)(m0 + r) * 512 + nt * 128 + c] = (h16)v; });
    }
    SYNC();
    if (PH(10)) for (int idx = blockIdx.x * 256 + otid(); idx < NTOK * 64; idx += gthreads) {
      const int tok = idx >> 6, c0 = (idx & 63) * 8;
      int s0, len; seq_of(tok, s0, len);
      const int wd = 2 << (c0 >> 7);
      const int pos = tok - s0;
      const int lo = max(pos - wd / 2, 0), hi = min(pos + wd / 2 - 1, len - 1);
      float sum[8];
#pragma unroll
      for (int j = 0; j < 8; ++j) sum[j] = 0.f;
#pragma unroll
      for (int k = 0; k < 16; ++k) {
        const int tt = lo + k;
        const bool ok = tt <= hi;
        const half8 z = *(const half8*)&zpa[(size_t)(s0 + (ok ? tt : hi)) * 512 + c0];
#pragma unroll
        for (int j = 0; j < 8; ++j) sum[j] += ok ? (float)z[j] : 0.f;
      }
      const half8 zc = *(const half8*)&zpa[(size_t)tok * 512 + c0];
      const float ic = __builtin_amdgcn_rcpf((float)(hi - lo + 1));
      half8 o;
#pragma unroll
      for (int j = 0; j < 8; ++j) o[j] = (h16)(sum[j] * ic - (float)zc[j]);
      *(half8*)&pa[(size_t)tok * 512 + c0] = o;
    }
    if (PH(11)) for (int item = blockIdx.x; item < 4096; item += gridDim.x)
      attn_item(item, zatt, cout_, p.in[2], p.in[17] + (size_t)L * 8, (h16*)smem, (h16*)(smem + 18432), (float*)(smem + 18432 + 17408));
    SYNC();
    if (PH(12)) for (int lj = xj.r; lj < 64 * 4; lj += xj.nrank) {
      int mt, g; xjob_map(xj, lj, 512, 4, mt, g); const int m0 = mt * 128;
      floatx16 acc[2][2]; acc_zero<2>(acc);
      gemm_core<2>(pa + (size_t)m0 * 512 + 128 * g, 512, Wt + WT_POOL + (size_t)g * 128 * 128, 128, 128, acc, As, Bs);
      const float* psc = p.in[5] + (size_t)L * 512 + 128 * g;
      epi_apply<2>(acc, [&](int r, int c, float v) { aout[(size_t)(m0 + r) * 512 + 128 * g + c] = (h16)(v * psc[c]); });
    }
    SYNC();
    if (PH(13)) for (int lj = xj.r; lj < 64 * 16; lj += xj.nrank) {
      int mt, nt; xjob_map(xj, lj, 512, 16, mt, nt); const int m0 = mt * 128, n0 = nt * 64;
      floatx16 mg[2][1]; acc_zero<1>(mg);
      for (int b = 0; b < 3; ++b) {
        floatx16 ag[2][1]; acc_zero<1>(ag);
        gemm_core<1>(x16 + (size_t)m0 * 1024, 1024, Wt + WT_IN + (size_t)(3200 + 1024 * b + n0) * 1024, 1024, 1024, ag, As, Bs);
        floatx16 ap[2][1]; acc_zero<1>(ap);
        const h16* br = b == 0 ? aout : (b == 1 ? bout : cout_);
        gemm_core<1>(br + (size_t)m0 * 512, 512, Wt + WT_BR + (size_t)(b * 1024 + n0) * 512, 512, 512, ap, As, Bs);
#pragma unroll
        for (int i = 0; i < 2; ++i)
#pragma unroll
          for (int r = 0; r < 16; ++r) mg[i][0][r] += sigmoidf_(ag[i][0][r]) * ap[i][0][r];
      }
      epi_apply<1>(mg, [&](int r, int c, float v) { merged[(size_t)(m0 + r) * 1024 + n0 + c] = (h16)v; });
    }
    SYNC();
    if (PH(14)) for (int lj = xj.r; lj < 64 * 8; lj += xj.nrank) {
      int mt, nt; xjob_map(xj, lj, 512, 8, mt, nt); const int m0 = mt * 128, n0 = nt * 128;
      floatx16 acc[2][2]; acc_init_resid<2>(acc, x16 + (size_t)m0 * 1024 + n0, 1024);
      gemm_core<2>(merged + (size_t)m0 * 1024, 1024, Wt + WT_O + (size_t)n0 * 1024, 1024, 1024, acc, As, Bs);
      epi_apply<2>(acc, [&](int r, int c, float v) { ypre1[(size_t)(m0 + r) * 1024 + n0 + c] = (h16)v; });
    }
    SYNC();
    if (PH(15)) ln_phase(ypre1, p.in[20] + (size_t)L * 1024, p.in[21] + (size_t)L * 1024, x16, nullptr, false, gw, nw);
    SYNC();
    for (int hf = 0; hf < 4; ++hf) {
      if (PH(16)) for (int lj = xj.r; lj < 16 * 32; lj += xj.nrank) {
        int mt, nt; xjob_map(xj, lj, 128, 32, mt, nt); const int m0 = mt * 128, n0 = nt * 128;
        floatx16 acc[2][2]; acc_zero<2>(acc);
        gemm_core<2>(x16 + (size_t)(hf * 16384 + m0) * 1024, 1024, Wt + WT_F1 + (size_t)n0 * 1024, 1024, 1024, acc, As, Bs);
        epi_apply<2>(acc, [&](int r, int c, float v) {
          const float u = fmaxf(v, 0.f);
          hid[(size_t)(m0 + r) * 4096 + n0 + c] = (h16)(u * u);
        });
      }
      SYNC();
      if (PH(17)) for (int lj = xj.r; lj < 16 * 8; lj += xj.nrank) {
        int mt, nt; xjob_map(xj, lj, 128, 8, mt, nt); const int m0 = mt * 128, n0 = nt * 128;
        floatx16 acc[2][2]; acc_init_resid<2>(acc, x16 + (size_t)(hf * 16384 + m0) * 1024 + n0, 1024);
        gemm_core<2>(hid + (size_t)m0 * 4096, 4096, Wt + WT_F2 + (size_t)n0 * 4096, 4096, 4096, acc, As, Bs);
        epi_apply<2>(acc, [&](int r, int c, float v) { ypre2[(size_t)(hf * 16384 + m0 + r) * 1024 + n0 + c] = (h16)v; });
      }
      SYNC();
    }
    if (PH(18)) ln_phase(ypre2, p.in[24] + (size_t)L * 1024, p.in[25] + (size_t)L * 1024, x16, p.out, L == 3, gw, nw);
    SYNC();
  }
}

extern "C" void kernel_launch(void* const* d_in, const int* in_sizes, int n_in, void* d_out, int out_size,
                              void* d_ws, size_t ws_size, hipStream_t stream) {
  static int grid_blocks = 0;
  if (!grid_blocks) {
    int dev = 0, cus = 0, per_cu = 0;
    hipGetDevice(&dev);
    hipDeviceGetAttribute(&cus, hipDeviceAttributeMultiprocessorCount, dev);
    hipOccupancyMaxActiveBlocksPerMultiprocessor(&per_cu, mega, 256, 0);
    if (per_cu > 2) per_cu = 2;
    if (per_cu < 1) per_cu = 1;
    grid_blocks = cus * per_cu;
  }
  Params p{};
  for (int i = 0; i < 26; ++i) p.in[i] = (const float*)d_in[i];
  p.out = (float*)d_out;
  p.ws = (char*)d_ws;
  hipMemsetAsync((char*)d_ws + W_BAR, 0, XCD_BAR_WORDS * sizeof(unsigned), stream);
  void* args[] = {&p};
  hipError_t e = hipLaunchCooperativeKernel((void*)mega, dim3(grid_blocks), dim3(256), args, 0, stream);
  if (e != hipSuccess) fprintf(stderr, "cooperative launch failed: %s (grid %d)\n", hipGetErrorString(e), grid_blocks);
}
```

```cpp
#include <hip/hip_runtime.h>
#include <hip/hip_fp16.h>
#include <hip/hip_cooperative_groups.h>
#include <cstdio>
#include <cstdint>
namespace cg = cooperative_groups;

typedef _Float16 h16;
typedef _Float16 half8 __attribute__((ext_vector_type(8)));
typedef _Float16 half4 __attribute__((ext_vector_type(4)));
typedef float floatx16 __attribute__((ext_vector_type(16)));
typedef float floatx4 __attribute__((ext_vector_type(4)));
typedef float float2v __attribute__((ext_vector_type(2)));
typedef unsigned int u32x4 __attribute__((ext_vector_type(4)));
typedef const __attribute__((address_space(4))) float2v* cf2p;

#define DI __device__ __forceinline__
#ifdef ONLY
#define PH(n) (ONLY == (n))
#else
#define PH(n) true
#endif

struct Params {
  const float* in[26];
  float* out;
  char* ws;
};

constexpr int NTOK = 65536;
constexpr size_t MiB = 1ull << 20;
constexpr size_t D_X16 = 0, D_BOUT = 128 * MiB, D_LORA = 192 * MiB, D_G16 = 240 * MiB;
constexpr size_t W_WT = 0;
constexpr size_t W_SB = 36 * MiB, W_PE = 324 * MiB, W_YBUF = 388 * MiB, W_ZPASS = 452 * MiB;
constexpr size_t W_ZPA = 36 * MiB, W_PA = 100 * MiB, W_AOUT = 260 * MiB, W_COUT = 324 * MiB, W_ZATT = 212 * MiB;
constexpr size_t W_MERGED = 36 * MiB, W_YPRE1 = 164 * MiB;
constexpr size_t W_HID = 36 * MiB, W_YPRE2 = 292 * MiB;
constexpr size_t W_BAR = 504 * MiB;
constexpr size_t WT_IN = 0, WT_BR = 6422528, WT_O = 7995392, WT_F1 = 9043968, WT_F2 = 13238272,
                 WT_POOL = 17432576, WT_W2 = 17498112, WT_A2 = 17563648, WT_G2 = 17629184;

constexpr float ALPHA = 1.681792830507429f;

DI void seq_of(int tok, int& s0, int& len) {
  if (tok < 32768) { s0 = tok & ~2047; len = 2048; }
  else { s0 = 32768 + ((tok - 32768) & ~16383); len = 16384; }
}
DI int otid() { int t = threadIdx.x; asm volatile("" : "+v"(t)); return t; }
template <int CTRL> DI float dppf(float v) {
  return __builtin_bit_cast(float, __builtin_amdgcn_mov_dpp(__builtin_bit_cast(int, v), CTRL, 0xf, 0xf, true));
}
DI float wave_sum(float v) {
  v += dppf<0xB1>(v);
  v += dppf<0x4E>(v);
  v += dppf<0x141>(v);
  v += dppf<0x140>(v);
  v += __builtin_bit_cast(float, __builtin_amdgcn_ds_swizzle(__builtin_bit_cast(int, v), 0x401F));
  const float a = __builtin_bit_cast(float, __builtin_amdgcn_readlane(__builtin_bit_cast(int, v), 0));
  const float b = __builtin_bit_cast(float, __builtin_amdgcn_readlane(__builtin_bit_cast(int, v), 32));
  return a + b;
}
DI float sigmoidf_(float x) { return __builtin_amdgcn_rcpf(1.f + __expf(-x)); }
DI float2v fma2(float2v a, float2v b, float2v c) { return __builtin_elementwise_fma(a, b, c); }

DI void tconv(const float* __restrict__ src, h16* __restrict__ dst, int K, int N, float* tile) {
  const int tn = N >> 6, tk = K >> 6, t = otid();
  for (int job = blockIdx.x; job < tk * tn; job += gridDim.x) {
    const int k0 = (job / tn) << 6, n0 = (job % tn) << 6;
    __syncthreads();
#pragma unroll
    for (int i = 0; i < 4; ++i) {
      const int k = (t >> 4) + 16 * i, n4 = (t & 15) * 4;
      const float4 v = *(const float4*)&src[(size_t)(k0 + k) * N + n0 + n4];
      tile[k * 65 + n4 + 0] = v.x; tile[k * 65 + n4 + 1] = v.y;
      tile[k * 65 + n4 + 2] = v.z; tile[k * 65 + n4 + 3] = v.w;
    }
    __syncthreads();
    const int n = t >> 2, ks = (t & 3) * 16;
    half8 o0, o1;
#pragma unroll
    for (int j = 0; j < 8; ++j) {
      o0[j] = (h16)tile[(ks + j) * 65 + n];
      o1[j] = (h16)tile[(ks + 8 + j) * 65 + n];
    }
    *(half8*)&dst[(size_t)(n0 + n) * K + k0 + ks] = o0;
    *(half8*)&dst[(size_t)(n0 + n) * K + k0 + ks + 8] = o1;
  }
}

template <int NJ>
DI void gemm_core(const h16* __restrict__ A, int lda, const h16* __restrict__ Bt, int ldb, int K,
                  floatx16 (&acc)[2][NJ], h16* As, h16* Bs) {
  const int t = otid(), l = t & 63, w = t >> 6, wm = w >> 1, wn = w & 1, h = l >> 5, lr = l & 31;
  u32x4 ra0[4], rb0[2 * NJ], ra1[4], rb1[2 * NJ];
  const h16* Ap = A + (size_t)(t >> 3) * lda + (t & 7) * 8;
  const h16* Bp = Bt + (size_t)(t >> 3) * ldb + (t & 7) * 8;
  const size_t sa = (size_t)32 * lda, sbb = (size_t)32 * ldb;
#define G_LOAD(RA, RB, k_) do { \
    _Pragma("unroll") for (int i = 0; i < 4; ++i) RA[i] = *(const u32x4*)&Ap[i * sa + (k_)]; \
    _Pragma("unroll") for (int i = 0; i < 2 * NJ; ++i) RB[i] = *(const u32x4*)&Bp[i * sbb + (k_)]; } while (0)
#define G_STEP(RA, RB, kn_) do { \
    __syncthreads(); \
    _Pragma("unroll") for (int i = 0; i < 4; ++i) *(u32x4*)&As[((t >> 3) + 32 * i) * 72 + (t & 7) * 8] = RA[i]; \
    _Pragma("unroll") for (int i = 0; i < 2 * NJ; ++i) *(u32x4*)&Bs[((t >> 3) + 32 * i) * 72 + (t & 7) * 8] = RB[i]; \
    __syncthreads(); \
    if ((kn_) < K) G_LOAD(RA, RB, kn_); \
    { half8 a[2][2], b[2][NJ]; \
      _Pragma("unroll") for (int i = 0; i < 2; ++i) a[0][i] = *(const half8*)&As[(wm * 64 + i * 32 + lr) * 72 + h * 8]; \
      _Pragma("unroll") for (int j = 0; j < NJ; ++j) b[0][j] = *(const half8*)&Bs[(wn * 32 * NJ + j * 32 + lr) * 72 + h * 8]; \
      _Pragma("unroll") for (int s = 0; s < 4; ++s) { \
        if (s < 3) { \
          _Pragma("unroll") for (int i = 0; i < 2; ++i) a[(s + 1) & 1][i] = *(const half8*)&As[(wm * 64 + i * 32 + lr) * 72 + (s + 1) * 16 + h * 8]; \
          _Pragma("unroll") for (int j = 0; j < NJ; ++j) b[(s + 1) & 1][j] = *(const half8*)&Bs[(wn * 32 * NJ + j * 32 + lr) * 72 + (s + 1) * 16 + h * 8]; \
        } \
        __builtin_amdgcn_sched_barrier(0); \
        _Pragma("unroll") for (int i = 0; i < 2; ++i) \
          _Pragma("unroll") for (int j = 0; j < NJ; ++j) \
            acc[i][j] = __builtin_amdgcn_mfma_f32_32x32x16_f16(a[s & 1][i], b[s & 1][j], acc[i][j], 0, 0, 0); \
        __builtin_amdgcn_sched_barrier(0); \
      } } } while (0)
  G_LOAD(ra0, rb0, 0);
  if (64 < K) G_LOAD(ra1, rb1, 64);
  for (int k0 = 0; k0 < K; k0 += 128) {
    G_STEP(ra0, rb0, k0 + 128);
    if (k0 + 64 < K) G_STEP(ra1, rb1, k0 + 192);
  }
#undef G_LOAD
#undef G_STEP
}
template <int NJ>
DI void acc_zero(floatx16 (&acc)[2][NJ]) {
#pragma unroll
  for (int i = 0; i < 2; ++i)
#pragma unroll
    for (int j = 0; j < NJ; ++j)
#pragma unroll
      for (int r = 0; r < 16; ++r) acc[i][j][r] = 0.f;
}
template <int NJ>
DI void acc_init_resid(floatx16 (&acc)[2][NJ], const h16* __restrict__ src, size_t ld) {
  const int t = otid(), l = t & 63, w = t >> 6, wm = w >> 1, wn = w & 1, h = l >> 5, lr = l & 31;
#pragma unroll
  for (int i = 0; i < 2; ++i)
#pragma unroll
    for (int j = 0; j < NJ; ++j) {
      const h16* b = src + (size_t)(wm * 64 + i * 32 + 4 * h) * ld + wn * 32 * NJ + j * 32 + lr;
#pragma unroll
      for (int r = 0; r < 16; ++r) acc[i][j][r] = ALPHA * (float)b[(size_t)((r & 3) + 8 * (r >> 2)) * ld];
    }
}
template <int NJ, class F>
DI void epi_apply(const floatx16 (&acc)[2][NJ], F f) {
  const int t = otid(), l = t & 63, w = t >> 6, wm = w >> 1, wn = w & 1, h = l >> 5, lr = l & 31;
#pragma unroll
  for (int i = 0; i < 2; ++i)
#pragma unroll
    for (int j = 0; j < NJ; ++j)
#pragma unroll
      for (int r = 0; r < 16; ++r) {
        f(wm * 64 + i * 32 + (r & 3) + 8 * (r >> 2) + 4 * h, wn * 32 * NJ + j * 32 + lr, acc[i][j][r]);
        if ((r & 3) == 3) __builtin_amdgcn_sched_barrier(0);
      }
}

DI void attn_item(int item, const h16* __restrict__ zpa, h16* __restrict__ cout, const float* __restrict__ rel_bias,
                  const float* __restrict__ sink_l, h16* Ks, h16* Vt, float* bt) {
  const int t = otid(), l = t & 63, w = t >> 6, h = l >> 5, lr = l & 31;
  const int hq = item & 7, qb = item >> 3;
  const int tok0 = qb * 128;
  int s0, len; seq_of(tok0, s0, len);
  const int nb = (tok0 - s0) >> 7, nblk = len >> 7;
  const int kvh = hq >> 2;
  __syncthreads();
  for (int r = t; r < 257; r += 256) {
    const int rel = r - 128;
    const int n = rel < 0 ? -rel : rel;
    int bk = n < 8 ? n : 8 + (n >= 12) + (n >= 16) + (n >= 23) + (n >= 32) + (n >= 46) + (n >= 64) + (n >= 91);
    if (rel > 0) bk += 16;
    bt[r] = rel_bias[bk * 8 + hq];
  }
  const int ql = w * 32 + lr;
  const int qtok = tok0 + ql;
  half8 qf[4];
#pragma unroll
  for (int ds = 0; ds < 4; ++ds) qf[ds] = *(const half8*)&zpa[(size_t)qtok * 768 + hq * 64 + ds * 16 + h * 8];
  float m = sink_l[hq], lsum = 1.f;
  floatx16 O[2];
#pragma unroll
  for (int dt = 0; dt < 2; ++dt)
#pragma unroll
    for (int r = 0; r < 16; ++r) O[dt][r] = 0.f;
  for (int kb = 0; kb < 3; ++kb) {
    const int kblk = nb - 1 + kb;
    if (kblk < 0 || kblk >= nblk) continue;
    const int ktok0 = s0 + kblk * 128;
    __syncthreads();
#pragma unroll
    for (int i = 0; i < 4; ++i) {
      const int c = t + 256 * i, key = c >> 3, seg = c & 7;
      const u32x4 kv = *(const u32x4*)&zpa[(size_t)(ktok0 + key) * 768 + 512 + kvh * 64 + seg * 8];
      *(u32x4*)&Ks[key * 72 + seg * 8] = kv;
      const half8 vv = *(const half8*)&zpa[(size_t)(ktok0 + key) * 768 + 640 + kvh * 64 + seg * 8];
      const int kl = key & 31;
      const int pos = (key & ~31) + (kl & 16) + ((kl >> 2) & 1) * 8 + ((kl >> 3) & 1) * 4 + (kl & 3);
#pragma unroll
      for (int e = 0; e < 8; ++e) Vt[(seg * 8 + e) * 136 + pos] = vv[e];
    }
    __syncthreads();
    floatx16 sc[4];
#pragma unroll
    for (int kt = 0; kt < 4; ++kt) {
#pragma unroll
      for (int r = 0; r < 16; ++r) sc[kt][r] = 0.f;
#pragma unroll
      for (int ds = 0; ds < 4; ++ds) {
        const half8 kf = *(const half8*)&Ks[(kt * 32 + lr) * 72 + ds * 16 + h * 8];
        sc[kt] = __builtin_amdgcn_mfma_f32_32x32x16_f16(kf, qf[ds], sc[kt], 0, 0, 0);
      }
    }
    float bmax = -1e30f;
#pragma unroll
    for (int kt = 0; kt < 4; ++kt)
#pragma unroll
      for (int r = 0; r < 16; ++r) {
        const int keyl = kt * 32 + (r & 3) + 8 * (r >> 2) + 4 * h;
        const int rel = (kb - 1) * 128 + keyl - ql;
        const bool ok = (rel >= -128) && (rel <= 128);
        const int ri = ok ? rel + 128 : 128;
        const float sv = ok ? sc[kt][r] * 0.125f + bt[ri] : -1e30f;
        sc[kt][r] = sv;
        bmax = fmaxf(bmax, sv);
      }
    bmax = fmaxf(bmax, __shfl_xor(bmax, 32));
    const float mnew = fmaxf(m, bmax);
    const float scale = __expf(m - mnew);
    float psum = 0.f;
#pragma unroll
    for (int kt = 0; kt < 4; ++kt)
#pragma unroll
      for (int r = 0; r < 16; ++r) {
        const float pv = __expf(sc[kt][r] - mnew);
        sc[kt][r] = pv;
        psum += pv;
      }
    psum += __shfl_xor(psum, 32);
    lsum = lsum * scale + psum;
    m = mnew;
#pragma unroll
    for (int dt = 0; dt < 2; ++dt)
#pragma unroll
      for (int r = 0; r < 16; ++r) O[dt][r] *= scale;
#pragma unroll
    for (int kt = 0; kt < 4; ++kt)
#pragma unroll
      for (int s = 0; s < 2; ++s) {
        half8 pf;
#pragma unroll
        for (int j = 0; j < 8; ++j) pf[j] = (h16)sc[kt][8 * s + j];
#pragma unroll
        for (int dt = 0; dt < 2; ++dt) {
          const half8 vf = *(const half8*)&Vt[(dt * 32 + lr) * 136 + kt * 32 + s * 16 + h * 8];
          O[dt] = __builtin_amdgcn_mfma_f32_32x32x16_f16(vf, pf, O[dt], 0, 0, 0);
        }
      }
  }
  const float inv = 1.f / lsum;
#pragma unroll
  for (int dt = 0; dt < 2; ++dt)
#pragma unroll
    for (int g = 0; g < 4; ++g) {
      half4 o;
#pragma unroll
      for (int e = 0; e < 4; ++e) o[e] = (h16)(O[dt][4 * g + e] * inv);
      *(half4*)&cout[(size_t)qtok * 512 + hq * 64 + dt * 32 + 8 * g + 4 * h] = o;
    }
}

template <int N> DI void fmac_bc(float& acc, float vec, float s) {
  asm("v_fmac_f32_dpp %0, %1, %2 row_newbcast:%3 row_mask:0xf bank_mask:0xf" : "+v"(acc) : "v"(vec), "v"(s), "i"(N));
}
template <int N> DI float mul_bc(float vec, float s) {
  float r;
  asm("v_mul_f32_dpp %0, %1, %2 row_newbcast:%3 row_mask:0xf bank_mask:0xf" : "=v"(r) : "v"(vec), "v"(s), "i"(N));
  return r;
}
struct ScanIn { floatx4 kk, w, nb, kd, r; float vi; };
struct ScanRaw { half4 kk, nb, kd, r; floatx4 w; h16 vi; };
DI floatx4 h4f(half4 v) { return floatx4{(float)v[0], (float)v[1], (float)v[2], (float)v[3]}; }
DI void pin4(floatx4& v) {
  float a = v[0], b = v[1], c = v[2], d = v[3];
  asm volatile("" : "+v"(a), "+v"(b), "+v"(c), "+v"(d));
  v = floatx4{a, b, c, d};
}
template <int MODE>
DI ScanRaw scan_ld(const float* __restrict__ sb, int c, int hh, int d, int s, unsigned o, unsigned lane) {
  const int tok = c * 128 + (d ? 127 - s : s);
  const float* p = sb + ((size_t)tok * 2 + hh) * 352;
  const h16* ph = (const h16*)(p + 128);
  const h16* pdh = ph + d * 128;
  ScanRaw in;
  in.kk = *(const half4*)&ph[o];
  in.w = *(const floatx4*)&p[d * 64 + o];
  in.nb = *(const half4*)&pdh[192 + o];
  if (MODE != 1) { in.kd = *(const half4*)&pdh[256 + o]; in.vi = ph[128 + lane]; }
  if (MODE == 2) in.r = *(const half4*)&ph[64 + o];
  return in;
}
#define SCAN_R4(M, b) M(b) M(b + 1) M(b + 2) M(b + 3)
#define SCAN_R16(M, b) SCAN_R4(M, b) SCAN_R4(M, b + 4) SCAN_R4(M, b + 8) SCAN_R4(M, b + 12)
#define SCAN_R64(M) SCAN_R16(M, 0) SCAN_R16(M, 16) SCAN_R16(M, 32) SCAN_R16(M, 48)
template <int MODE>
DI float scan_step(float (&S)[64], const ScanRaw& raw) {
  ScanIn in;
  in.kk = h4f(raw.kk); in.w = raw.w; in.nb = h4f(raw.nb);
  if (MODE != 1) { in.kd = h4f(raw.kd); in.vi = (float)raw.vi; }
  if (MODE == 2) in.r = h4f(raw.r);
  pin4(in.kk); pin4(in.w); pin4(in.nb);
  if (MODE != 1) { pin4(in.kd); asm volatile("" : "+v"(in.vi)); }
  if (MODE == 2) pin4(in.r);
  __builtin_amdgcn_sched_barrier(0);
  asm volatile("s_nop 4");
  float dd[8], yy[8];
#pragma unroll
  for (int k = 0; k < 8; ++k) { dd[k] = 0.f; yy[k] = 0.f; }
#define SC_DOT(j) fmac_bc<((j) >> 2)>(dd[(j) & 7], in.kk[(j) & 3], S[j]);
  SCAN_R64(SC_DOT)
  const float dot = ((dd[0] + dd[1]) + (dd[2] + dd[3])) + ((dd[4] + dd[5]) + (dd[6] + dd[7]));
#define SC_U1(b, k) t_[k] = mul_bc<(((b) + (k)) >> 2)>(in.nb[((b) + (k)) & 3], dot);
#define SC_U2(b, k) if (MODE != 1) fmac_bc<(((b) + (k)) >> 2)>(t_[k], in.kd[((b) + (k)) & 3], in.vi);
#define SC_U3(b, k) fmac_bc<(((b) + (k)) >> 2)>(t_[k], in.w[((b) + (k)) & 3], S[(b) + (k)]); S[(b) + (k)] = t_[k];
#define SC_U4(b, k) if (MODE == 2) fmac_bc<(((b) + (k)) >> 2)>(yy[k], in.r[((b) + (k)) & 3], t_[k]);
#define SC_A8(M, b) M(b, 0) M(b, 1) M(b, 2) M(b, 3) M(b, 4) M(b, 5) M(b, 6) M(b, 7)
#define SC_G(b) { float t_[8]; SC_A8(SC_U1, b) SC_A8(SC_U2, b) SC_A8(SC_U3, b) SC_A8(SC_U4, b) }
  SC_G(0) SC_G(8) SC_G(16) SC_G(24) SC_G(32) SC_G(40) SC_G(48) SC_G(56)
  __builtin_amdgcn_sched_barrier(0);
  return ((yy[0] + yy[1]) + (yy[2] + yy[3])) + ((yy[4] + yy[5]) + (yy[6] + yy[7]));
}
template <int MODE>
DI void scan_item(const float* __restrict__ sb, float* __restrict__ pe, float* __restrict__ ybuf, int item, int lane) {
  const int c = item >> 2, hh = (item >> 1) & 1, d = item & 1;
  float S[64];
  float* pbase = pe + (size_t)item * 8192;
  if (MODE == 2) {
#pragma unroll
    for (int j = 0; j < 16; ++j) {
      const floatx4 v = *(const floatx4*)&pbase[4096 + lane * 64 + 4 * j];
      S[4 * j] = v[0]; S[4 * j + 1] = v[1]; S[4 * j + 2] = v[2]; S[4 * j + 3] = v[3];
    }
  } else {
#pragma unroll
    for (int j = 0; j < 64; ++j) S[j] = (MODE == 1 && j == lane) ? 1.f : 0.f;
  }
  float* yout = ybuf + (size_t)d * NTOK * 128 + hh * 64 + lane;
  const unsigned o = 4u * (lane & 15), ul = lane;
  ScanRaw r0 = scan_ld<MODE>(sb, c, hh, d, 0, o, ul), r1 = scan_ld<MODE>(sb, c, hh, d, 1, o, ul), r2 = scan_ld<MODE>(sb, c, hh, d, 2, o, ul);
  for (int s = 0; s < 128; s += 4) {
    ScanRaw r3 = scan_ld<MODE>(sb, c, hh, d, s + 3, o, ul);
    float y = scan_step<MODE>(S, r0);
    if (MODE == 2) yout[(size_t)(c * 128 + (d ? 127 - s : s)) * 128] = y;
    r0 = scan_ld<MODE>(sb, c, hh, d, min(s + 4, 127), o, ul);
    y = scan_step<MODE>(S, r1);
    if (MODE == 2) yout[(size_t)(c * 128 + (d ? 126 - s : s + 1)) * 128] = y;
    r1 = scan_ld<MODE>(sb, c, hh, d, min(s + 5, 127), o, ul);
    y = scan_step<MODE>(S, r2);
    if (MODE == 2) yout[(size_t)(c * 128 + (d ? 125 - s : s + 2)) * 128] = y;
    r2 = scan_ld<MODE>(sb, c, hh, d, min(s + 6, 127), o, ul);
    y = scan_step<MODE>(S, r3);
    if (MODE == 2) yout[(size_t)(c * 128 + (d ? 124 - s : s + 3)) * 128] = y;
  }
  if (MODE == 0) {
    float* o = pbase + 4096 + lane * 64;
#pragma unroll
    for (int j = 0; j < 16; ++j) *(floatx4*)&o[4 * j] = floatx4{S[4 * j], S[4 * j + 1], S[4 * j + 2], S[4 * j + 3]};
  }
  if (MODE == 1) {
    h16* pf = (h16*)pbase + (((lane >> 5) * 64 + ((lane >> 2) & 3) * 16) * 8 + 4 * ((lane >> 4) & 1) + (lane & 3));
#pragma unroll
    for (int j = 0; j < 64; ++j) pf[(j >> 4) * 1024 + (j & 15) * 8] = (h16)S[j];
  }
}
template <bool L3>
DI void scan_l13(const float* __restrict__ sb, float* __restrict__ pe, float* __restrict__ ybuf, int gw, int nw) {
  const int lane = otid() & 63;
  if (L3) {
    for (int item = gw; item < 2048; item += nw) scan_item<2>(sb, pe, ybuf, item, lane);
  } else {
    for (int it = gw; it < 2048; it += nw) scan_item<0>(sb, pe, ybuf, it, lane);
    for (int it = gw; it < 2048; it += nw) scan_item<1>(sb, pe, ybuf, it, lane);
  }
}

DI void scan_l2(float* __restrict__ pe, char* lds) {
  const int t = otid(), l = t & 63, rg = t >> 6, g = l >> 4, lc = l & 15;
  for (int ch = blockIdx.x; ch < 72; ch += gridDim.x) {
    const int seq = ch >> 2, hh = (ch >> 1) & 1, d = ch & 1;
    const int c0 = seq < 16 ? seq * 16 : 256 + (seq - 16) * 128;
    const int n = seq < 16 ? 16 : 128;
    const int i = rg * 16 + lc;
    floatx4 S[4];
#pragma unroll
    for (int mt = 0; mt < 4; ++mt) S[mt] = floatx4{0.f, 0.f, 0.f, 0.f};
    u32x4 pr[4][2]; floatx4 er[4][4];
#define L2_LOAD(k_, u_) do { const int c_ = d ? c0 + n - 1 - (k_) : c0 + (k_); \
      const float* b_ = pe + (size_t)(c_ * 4 + hh * 2 + d) * 8192; \
      pr[u_][0] = *(const u32x4*)((const char*)b_ + t * 16); pr[u_][1] = *(const u32x4*)((const char*)b_ + 4096 + t * 16); \
      _Pragma("unroll") for (int mt = 0; mt < 4; ++mt) er[u_][mt] = *(const floatx4*)&b_[4096 + i * 64 + 16 * mt + 4 * g]; } while (0)
    L2_LOAD(0, 0); L2_LOAD(1, 1); L2_LOAD(2, 2); L2_LOAD(3, 3);
    for (int k = 0; k < n; k += 4) {
#pragma unroll
      for (int u = 0; u < 4; ++u) {
        const int kk = k + u;
        char* slot = lds + (u & 1) * 8192;
        *(u32x4*)(slot + t * 16) = pr[u][0];
        *(u32x4*)(slot + 4096 + t * 16) = pr[u][1];
        floatx4 E[4];
#pragma unroll
        for (int mt = 0; mt < 4; ++mt) E[mt] = er[u][mt];
        if (kk + 4 < n) L2_LOAD(kk + 4, u);
        __syncthreads();
        const int c = d ? c0 + n - 1 - kk : c0 + kk;
        float* Em = pe + (size_t)(c * 4 + hh * 2 + d) * 8192 + 4096;
        half8 bf[2];
#pragma unroll
        for (int kb = 0; kb < 2; ++kb)
#pragma unroll
          for (int e = 0; e < 8; ++e) bf[kb][e] = (h16)S[2 * kb + (e >> 2)][e & 3];
#pragma unroll
        for (int mt = 0; mt < 4; ++mt) *(floatx4*)&Em[i * 64 + 16 * mt + 4 * g] = S[mt];
#pragma unroll
        for (int mt = 0; mt < 4; ++mt) {
          floatx4 a = E[mt];
#pragma unroll
          for (int kb = 0; kb < 2; ++kb) {
            const half8 af = *(const half8*)(slot + ((mt * 2 + kb) * 64 + l) * 16);
            a = __builtin_amdgcn_mfma_f32_16x16x32_f16(af, bf[kb], a, 0, 0, 0);
          }
          S[mt] = a;
        }
      }
    }
    __syncthreads();
  }
}

DI void ln_phase(const h16* __restrict__ y, const float* __restrict__ gam, const float* __restrict__ bet,
                 h16* __restrict__ x16, float* __restrict__ outf, bool final_, int gw, int nw) {
  const int lane = otid() & 63;
  for (int tok = gw; tok < NTOK; tok += nw) {
    const half8 a = *(const half8*)&y[(size_t)tok * 1024 + lane * 8];
    const half8 b = *(const half8*)&y[(size_t)tok * 1024 + 512 + lane * 8];
    float v[16];
    float s = 0.f;
#pragma unroll
    for (int j = 0; j < 8; ++j) { v[j] = (float)a[j]; v[8 + j] = (float)b[j]; s += v[j] + v[8 + j]; }
    const float mu = wave_sum(s) * (1.f / 1024.f);
    float q = 0.f;
#pragma unroll
    for (int j = 0; j < 16; ++j) { const float dd = v[j] - mu; q += dd * dd; }
    const float rstd = rsqrtf(wave_sum(q) * (1.f / 1024.f) + 1e-5f);
    float o[16];
#pragma unroll
    for (int j = 0; j < 8; ++j) {
      o[j] = (v[j] - mu) * rstd * gam[lane * 8 + j] + bet[lane * 8 + j];
      o[8 + j] = (v[8 + j] - mu) * rstd * gam[512 + lane * 8 + j] + bet[512 + lane * 8 + j];
    }
    if (final_) {
      float* op = outf + (size_t)tok * 1024;
      *(float4*)&op[lane * 8] = float4{o[0], o[1], o[2], o[3]};
      *(float4*)&op[lane * 8 + 4] = float4{o[4], o[5], o[6], o[7]};
      *(float4*)&op[512 + lane * 8] = float4{o[8], o[9], o[10], o[11]};
      *(float4*)&op[512 + lane * 8 + 4] = float4{o[12], o[13], o[14], o[15]};
    } else {
      half8 oa, ob;
#pragma unroll
      for (int j = 0; j < 8; ++j) { oa[j] = (h16)o[j]; ob[j] = (h16)o[8 + j]; }
      *(half8*)&x16[(size_t)tok * 1024 + lane * 8] = oa;
      *(half8*)&x16[(size_t)tok * 1024 + 512 + lane * 8] = ob;
    }
  }
}

#define XB_TMO      128
#define XB_XCNT(j)  (256  + 64 * (j))
#define XB_XSUB(j)  (1280 + 64 * (j))
#define XB_XGEN(j)  (2304 + 64 * (j))
#define XB_TOP      3328
#define XB_TOPGEN   3392
#define XCD_BAR_WORDS 3456
#define XB_SPIN_CAP (1u << 18)
#define LAS __attribute__((address_space(3)))
DI unsigned xb_ld(unsigned* p) { return __hip_atomic_load(p, __ATOMIC_RELAXED, __HIP_MEMORY_SCOPE_AGENT); }
DI unsigned xb_add(unsigned* p, unsigned v) { return __hip_atomic_fetch_add(p, v, __ATOMIC_RELAXED, __HIP_MEMORY_SCOPE_AGENT); }
DI unsigned xb_xcc_id() { return (unsigned)__builtin_amdgcn_s_getreg((3 << 11) | 20) & 0xFu; }
#define XB_SPIN(cond, bar) do { unsigned _sp = 0; while (cond) { __builtin_amdgcn_s_sleep(1); \
    if ((++_sp & 255u) == 0u) { if (xb_ld(&(bar)[XB_TMO])) break; if (_sp > XB_SPIN_CAP) { atomicAdd(&(bar)[XB_TMO], 1u); break; } } } } while (0)
struct XcdBarrier { unsigned* bar; unsigned x; volatile LAS unsigned* st; };
DI XcdBarrier xcd_barrier_post(unsigned* bar, volatile LAS unsigned* st) {
  XcdBarrier b; b.bar = bar; b.x = xb_xcc_id(); b.st = st;
  if (threadIdx.x == 0) (void)xb_add(&bar[XB_XCNT(b.x)], 1u);
  return b;
}
DI void xcd_barrier_complete(unsigned* bar, unsigned x, unsigned& nloc, unsigned& nx) {
  const unsigned G = gridDim.x * gridDim.y * gridDim.z;
  unsigned sum, cnt, mine, sp = 0u;
  for (;;) {
    sum = 0u; cnt = 0u; mine = 0u;
#pragma unroll
    for (unsigned j = 0; j < 16; ++j) { const unsigned c = xb_ld(&bar[XB_XCNT(j)]); sum += c; cnt += (c > 0u) ? 1u : 0u; mine = (j == x) ? c : mine; }
    if (sum == G) break;
    __builtin_amdgcn_s_sleep(1);
    if ((++sp & 255u) == 0u) { if (xb_ld(&bar[XB_TMO])) break; if (sp > XB_SPIN_CAP) { atomicAdd(&bar[XB_TMO], 1u); break; } }
  }
  nloc = mine > 0u ? mine : 1u; nx = cnt > 0u ? cnt : 1u;
}
DI void xcd_barrier(const XcdBarrier& b) {
  asm volatile("s_waitcnt vmcnt(0)" ::: "memory");
  __syncthreads();
  if (threadIdx.x == 0) {
    unsigned* bar = b.bar;
    __builtin_amdgcn_s_waitcnt(0);
    unsigned nloc = b.st[0], nx = b.st[1];
    if (nloc == 0u) { xcd_barrier_complete(bar, b.x, nloc, nx); b.st[0] = nloc; b.st[1] = nx; }
    const unsigned old = xb_add(&bar[XB_XSUB(b.x)], 1u);
    const unsigned gen = old / nloc;
    if (old + 1u == (gen + 1u) * nloc) {
      __builtin_amdgcn_fence(__ATOMIC_RELEASE, "agent");
      asm volatile("s_waitcnt vmcnt(0)" ::: "memory");
      const unsigned og = xb_add(&bar[XB_TOP], 1u);
      const unsigned tg = og / nx;
      if (og + 1u == (tg + 1u) * nx) xb_add(&bar[XB_TOPGEN], 1u);
      else XB_SPIN(xb_ld(&bar[XB_TOPGEN]) == tg, bar);
      __builtin_amdgcn_fence(__ATOMIC_ACQUIRE, "agent");
      xb_add(&bar[XB_XGEN(b.x)], 1u);
      asm volatile("s_waitcnt vmcnt(0)" ::: "memory");
    } else {
      XB_SPIN(xb_ld(&bar[XB_XGEN(b.x)]) == gen, bar);
      __builtin_amdgcn_fence(__ATOMIC_ACQUIRE, "agent");
      asm volatile("s_waitcnt vmcnt(0)" ::: "memory");
    }
  }
  __syncthreads();
}

struct XJob { int x, r, nrank; };
DI XJob xjob_init() { XJob j; j.x = blockIdx.x & 7; j.r = blockIdx.x >> 3; j.nrank = gridDim.x >> 3; return j; }
DI void xjob_map(const XJob& xj, int lj, int MT, int NT, int& mt, int& nt) {
  int mtx;
  if ((NT & 7) == 0) {
    const int p = lj >> 6, q = lj & 63, npn = NT >> 3;
    nt = (p % npn) * 8 + (q & 7);
    mtx = (p / npn) * 8 + (q >> 3);
  } else { mtx = lj / NT; nt = lj % NT; }
  mt = xj.x * (MT >> 3) + mtx;
}

__global__ void __launch_bounds__(256, 2) mega(Params p) {
  cg::grid_group grid = cg::this_grid();
  __shared__ __attribute__((aligned(16))) char smem[40960];
  h16* As = (h16*)smem;
  h16* Bs = (h16*)(smem + 18432);
  const int t = threadIdx.x;
  const int gw = __builtin_amdgcn_readfirstlane((int)(blockIdx.x * 4 + (t >> 6)));
  const int nw = gridDim.x * 4;
  const int gtid = blockIdx.x * 256 + t, gthreads = gridDim.x * 256;
  const int lane = t & 63;
  const XJob xj = xjob_init();

  char* D = (char*)p.out;
  char* W = p.ws;
  h16* x16 = (h16*)(D + D_X16);
  h16* bout = (h16*)(D + D_BOUT);
  h16* lorain = (h16*)(D + D_LORA);
  h16* g16 = (h16*)(D + D_G16);
  h16* Wt = (h16*)(W + W_WT);
  float* sb = (float*)(W + W_SB);
  float* pe = (float*)(W + W_PE);
  float* ybuf = (float*)(W + W_YBUF);
  h16* zpass = (h16*)(W + W_ZPASS);
  h16* zpa = (h16*)(W + W_ZPA);
  h16* zatt = (h16*)(W + W_ZATT);
  h16* pa = (h16*)(W + W_PA);
  h16* aout = (h16*)(W + W_AOUT);
  h16* cout_ = (h16*)(W + W_COUT);
  h16* merged = (h16*)(W + W_MERGED);
  h16* ypre1 = (h16*)(W + W_YPRE1);
  h16* hid = (h16*)(W + W_HID);
  h16* ypre2 = (h16*)(W + W_YPRE2);

  __shared__ u32x4 xb_words;
  if (threadIdx.x == 0) xb_words = u32x4{0u, 0u, 0u, 0u};
  __syncthreads();
  XcdBarrier xb = xcd_barrier_post((unsigned*)(W + W_BAR), (volatile LAS unsigned*)&xb_words);
  grid.sync();
#define SYNC() xcd_barrier(xb)

  if (PH(19)) for (int idx = blockIdx.x * 256 + otid(); idx < NTOK * 128; idx += gthreads) {
    const size_t e = (size_t)idx * 8;
    const float* src = e < (size_t)32768 * 1024 ? p.in[0] + e : p.in[1] + (e - (size_t)32768 * 1024);
    const float4 a = *(const float4*)src, b = *(const float4*)(src + 4);
    half8 o;
    o[0] = (h16)a.x; o[1] = (h16)a.y; o[2] = (h16)a.z; o[3] = (h16)a.w;
    o[4] = (h16)b.x; o[5] = (h16)b.y; o[6] = (h16)b.z; o[7] = (h16)b.w;
    *(half8*)&x16[e] = o;
  }

  for (int L = 0; L < 4; ++L) {
    if (PH(20)) {
      float* tile = (float*)smem;
      tconv(p.in[3] + (size_t)L * 1024 * 6272, Wt + WT_IN, 1024, 6272, tile);
      for (int b = 0; b < 3; ++b)
        tconv(p.in[18] + ((size_t)L * 3 + b) * 512 * 1024, Wt + WT_BR + (size_t)b * 1024 * 512, 512, 1024, tile);
      tconv(p.in[19] + (size_t)L * 1024 * 1024, Wt + WT_O, 1024, 1024, tile);
      tconv(p.in[22] + (size_t)L * 1024 * 4096, Wt + WT_F1, 1024, 4096, tile);
      tconv(p.in[23] + (size_t)L * 4096 * 1024, Wt + WT_F2, 4096, 1024, tile);
      for (int g = 0; g < 4; ++g)
        tconv(p.in[4] + ((size_t)L * 4 + g) * 128 * 128, Wt + WT_POOL + (size_t)g * 128 * 128, 128, 128, tile);
      for (int d = 0; d < 2; ++d) {
        tconv(p.in[8] + ((size_t)L * 2 + d) * 64 * 512, Wt + WT_W2 + (size_t)d * 512 * 64, 64, 512, tile);
        tconv(p.in[10] + ((size_t)L * 2 + d) * 64 * 512, Wt + WT_A2 + (size_t)d * 512 * 64, 64, 512, tile);
      }
      tconv(p.in[11] + (size_t)L * 128 * 512, Wt + WT_G2, 128, 512, tile);
    }
    SYNC();
    const float* mu = p.in[6] + (size_t)L * 1920;

    if (PH(1)) for (int lj = xj.r; lj < 64 * 3; lj += xj.nrank) {
      int mt, nt; xjob_map(xj, lj, 512, 3, mt, nt); const int m0 = mt * 128;
      floatx16 acc[2][2]; acc_zero<2>(acc);
      gemm_core<2>(x16 + (size_t)m0 * 1024, 1024, Wt + WT_IN + (size_t)(2048 + nt * 128) * 1024, 1024, 1024, acc, As, Bs);
      epi_apply<2>(acc, [&](int r, int c, float v) { zpass[(size_t)(m0 + r) * 384 + nt * 128 + c] = (h16)v; });
    }
    SYNC();
    if (PH(2)) for (int idx = blockIdx.x * 256 + otid(); idx < NTOK * 48; idx += gthreads) {
      const int tok = idx / 48, c0 = (idx % 48) * 8;
      int s0, len; seq_of(tok, s0, len);
      const half8 z = *(const half8*)&zpass[(size_t)tok * 384 + c0];
      const bool hp = tok > s0, hn = tok < s0 + len - 1;
      half8 zp = *(const half8*)&zpass[(size_t)(tok - (hp ? 1 : 0)) * 384 + c0];
      half8 zn = *(const half8*)&zpass[(size_t)(tok + (hn ? 1 : 0)) * 384 + c0];
#pragma unroll
      for (int j = 0; j < 8; ++j) { zp[j] = hp ? zp[j] : (h16)0.f; zn[j] = hn ? zn[j] : (h16)0.f; }
      half8 o;
#pragma unroll
      for (int j = 0; j < 8; ++j) {
        const float u0 = (float)z[j];
        const float u = u0 + mu[1536 + c0 + j] * (0.5f * ((float)zp[j] + (float)zn[j]) - u0);
        const float th = 1.f - 2.f * __builtin_amdgcn_rcpf(1.f + __expf(2.f * u));
        const float r = c0 < 128 ? th : (c0 < 256 ? u : sigmoidf_(u));
        o[j] = (h16)r;
      }
      *(half8*)&lorain[(size_t)tok * 384 + c0] = o;
    }
    SYNC();

    for (int ps = 0; ps < 4; ++ps) {
      const int njt = ps == 0 ? 8 : 5;
      if (PH(3)) for (int lj = xj.r; lj < 64 * njt; lj += xj.nrank) {
        const int mt = xj.x * 64 + lj / njt, jt = ps == 0 ? ((lj + (lj >> 6)) & 7) : 3 + lj % 5, m0 = mt * 128;
        floatx16 acc[2][2]; acc_zero<2>(acc);
        if (jt < 3) {
          gemm_core<2>(x16 + (size_t)m0 * 1024, 1024, Wt + WT_IN + (size_t)(512 + jt * 512 + 128 * ps) * 1024, 1024, 1024, acc, As, Bs);
          epi_apply<2>(acc, [&](int r, int c, float v) { zpass[(size_t)(m0 + r) * 384 + jt * 128 + c] = (h16)v; });
        } else if (jt < 5) {
          const int d = jt - 3;
          gemm_core<2>(lorain + (size_t)m0 * 384 + 64 * d, 384, Wt + WT_W2 + (size_t)(d * 512 + 128 * ps) * 64, 64, 64, acc, As, Bs);
          const float* w0 = p.in[7] + ((size_t)L * 2 + d) * 512 + 128 * ps;
          const int cc_ = ((otid() >> 6) & 1) * 64 + (otid() & 31);
          const float w0v[2] = {w0[cc_], w0[cc_ + 32]};
          epi_apply<2>(acc, [&](int r, int c, float v) {
            const float x = -(((c >> 5) & 1 ? w0v[1] : w0v[0]) + v);
            const float sp = fmaxf(x, 0.f) + __logf(1.f + __expf(-fabsf(x)));
            const float dec = __expf(-__expf(-sp - 0.5f));
            sb[((size_t)(m0 + r) * 2 + (c >> 6)) * 352 + d * 64 + (c & 63)] = dec;
          });
        } else if (jt < 7) {
          const int d = jt - 5;
          gemm_core<2>(lorain + (size_t)m0 * 384 + 128 + 64 * d, 384, Wt + WT_A2 + (size_t)(d * 512 + 128 * ps) * 64, 64, 64, acc, As, Bs);
          const float* a0 = p.in[9] + ((size_t)L * 2 + d) * 512 + 128 * ps;
          const int cc_ = ((otid() >> 6) & 1) * 64 + (otid() & 31);
          const float a0v[2] = {a0[cc_], a0[cc_ + 32]};
          epi_apply<2>(acc, [&](int r, int c, float v) {
            ((h16*)(sb + ((size_t)(m0 + r) * 2 + (c >> 6)) * 352 + 128))[192 + 128 * d + (c & 63)] = (h16)sigmoidf_(((c >> 5) & 1 ? a0v[1] : a0v[0]) + v);
          });
        } else {
          gemm_core<2>(lorain + (size_t)m0 * 384 + 256, 384, Wt + WT_G2 + (size_t)(128 * ps) * 128, 128, 128, acc, As, Bs);
          epi_apply<2>(acc, [&](int r, int c, float v) { g16[(size_t)(m0 + r) * 128 + c] = (h16)v; });
        }
      }
      SYNC();
      if (PH(4)) {
        const int lane = otid() & 63;
        const float* kk_w = p.in[12] + (size_t)L * 512 + 128 * ps;
        const float* ka_w = p.in[13] + (size_t)L * 512 + 128 * ps;
        float muc[2][3], kkc[2], kac[2];
#pragma unroll
        for (int hh = 0; hh < 2; ++hh) {
          const int cl = 64 * hh + lane;
#pragma unroll
          for (int q = 0; q < 3; ++q) muc[hh][q] = mu[q * 512 + 128 * ps + cl];
          kkc[hh] = kk_w[cl]; kac[hh] = ka_w[cl];
        }
        for (int tb = gw; tb < NTOK; tb += 2 * nw) {
          float z0[2][2][3], zm[2][2][3], zn[2][2][3], af[2][2], ab[2][2];
#pragma unroll
          for (int u = 0; u < 2; ++u) {
            const int tok = tb + u * nw;
            int s0, len; seq_of(tok, s0, len);
            const bool hp = tok > s0, hn = tok < s0 + len - 1;
            const h16* zp = zpass + (size_t)tok * 384;
#pragma unroll
            for (int hh = 0; hh < 2; ++hh) {
              const int cl = 64 * hh + lane;
#pragma unroll
              for (int q = 0; q < 3; ++q) {
                z0[u][hh][q] = (float)zp[q * 128 + cl];
                const float a_ = (float)zp[q * 128 + cl - (hp ? 384 : 0)];
                const float b_ = (float)zp[q * 128 + cl + (hn ? 384 : 0)];
                zm[u][hh][q] = hp ? a_ : 0.f; zn[u][hh][q] = hn ? b_ : 0.f;
              }
              const h16* sp = (const h16*)(sb + ((size_t)tok * 2 + hh) * 352 + 128);
              af[u][hh] = (float)sp[192 + lane]; ab[u][hh] = (float)sp[320 + lane];
            }
          }
#pragma unroll
          for (int u = 0; u < 2; ++u) {
            const int tok = tb + u * nw;
#pragma unroll
            for (int hh = 0; hh < 2; ++hh) {
              float uu[3];
#pragma unroll
              for (int q = 0; q < 3; ++q) uu[q] = z0[u][hh][q] + muc[hh][q] * (0.5f * (zm[u][hh][q] + zn[u][hh][q]) - z0[u][hh][q]);
              const float r = uu[0], k = uu[1], v = uu[2];
              const float kkr = k * kkc[hh];
              const float kk = kkr * __builtin_amdgcn_rsqf(fmaxf(wave_sum(kkr * kkr), 1e-24f));
              h16* sp = (h16*)(sb + ((size_t)tok * 2 + hh) * 352 + 128);
              const float ka = kac[hh], a1 = af[u][hh], a2 = ab[u][hh];
              sp[lane] = (h16)kk; sp[64 + lane] = (h16)r; sp[128 + lane] = (h16)v;
              sp[192 + lane] = (h16)(-kk * a1); sp[256 + lane] = (h16)(k * (1.f + (a1 - 1.f) * ka));
              sp[320 + lane] = (h16)(-kk * a2); sp[384 + lane] = (h16)(k * (1.f + (a2 - 1.f) * ka));
            }
          }
        }
      }
      SYNC();
      if (PH(5)) scan_l13<false>(sb, pe, ybuf, gw, nw);
      SYNC();
      if (PH(6)) {
        if (blockIdx.x < 72) scan_l2(pe, smem);
        else if (ps == 3) {
          const int r2 = (blockIdx.x - 72) >> 3, nr2 = (gridDim.x - 72) >> 3;
          for (int lj = r2; lj < 64 * 6; lj += nr2) {
            const int mt = xj.x * 64 + lj / 6, nt = lj % 6, m0 = mt * 128;
            floatx16 acc[2][2]; acc_zero<2>(acc);
            gemm_core<2>(x16 + (size_t)m0 * 1024, 1024, Wt + WT_IN + (size_t)(2432 + nt * 128) * 1024, 1024, 1024, acc, As, Bs);
            epi_apply<2>(acc, [&](int r, int c, float v) { zatt[(size_t)(m0 + r) * 768 + nt * 128 + c] = (h16)v; });
          }
        } else {
          const int r2 = (blockIdx.x - 72) >> 3, nr2 = (gridDim.x - 72) >> 3;
          for (int lj = r2; lj < 64 * 3; lj += nr2) {
            const int mt = xj.x * 64 + lj / 3, jt = lj % 3, m0 = mt * 128;
            floatx16 acc[2][2]; acc_zero<2>(acc);
            gemm_core<2>(x16 + (size_t)m0 * 1024, 1024, Wt + WT_IN + (size_t)(512 + jt * 512 + 128 * (ps + 1)) * 1024, 1024, 1024, acc, As, Bs);
            epi_apply<2>(acc, [&](int r, int c, float v) { zpass[(size_t)(m0 + r) * 384 + jt * 128 + c] = (h16)v; });
          }
        }
      }
      SYNC();
      if (PH(7)) scan_l13<true>(sb, pe, ybuf, gw, nw);
      SYNC();
      if (PH(8)) {
        const int lane = otid() & 63;
        const float* rk = p.in[14] + (size_t)L * 512 + 128 * ps;
        const float* gng = p.in[15] + (size_t)L * 512 + 128 * ps;
        const float* gnb = p.in[16] + (size_t)L * 512 + 128 * ps;
        float rkc[2], ggc[2], gbc[2];
#pragma unroll
        for (int hh = 0; hh < 2; ++hh) { rkc[hh] = rk[64 * hh + lane]; ggc[hh] = gng[64 * hh + lane]; gbc[hh] = gnb[64 * hh + lane]; }
        for (int tb = gw; tb < NTOK; tb += 2 * nw) {
          float yv[2][2], rr[2][2], vv[2][2], kb_[2][2], gg[2][2];
#pragma unroll
          for (int u = 0; u < 2; ++u) {
            const int tok = tb + u * nw;
#pragma unroll
            for (int hh = 0; hh < 2; ++hh) {
              const int cl = 64 * hh + lane;
              yv[u][hh] = ybuf[(size_t)tok * 128 + cl] + ybuf[((size_t)NTOK + tok) * 128 + cl];
              const h16* sp = (const h16*)(sb + ((size_t)tok * 2 + hh) * 352 + 128);
              rr[u][hh] = (float)sp[64 + lane]; vv[u][hh] = (float)sp[128 + lane];
              kb_[u][hh] = 0.5f * ((float)sp[256 + lane] + (float)sp[384 + lane]);
              gg[u][hh] = (float)g16[(size_t)tok * 128 + cl];
            }
          }
#pragma unroll
          for (int u = 0; u < 2; ++u) {
            const int tok = tb + u * nw;
#pragma unroll
            for (int hh = 0; hh < 2; ++hh) {
              const int cl = 64 * hh + lane;
              const float y = yv[u][hh];
              const float mean = wave_sum(y) * (1.f / 64.f);
              const float dy = y - mean;
              const float var = wave_sum(dy * dy) * (1.f / 64.f);
              const float yn = dy * rsqrtf(var + 64e-5f) * ggc[hh] + gbc[hh];
              const float bs = wave_sum(rr[u][hh] * kb_[u][hh] * rkc[hh]);
              const float o = (yn + bs * vv[u][hh]) * gg[u][hh];
              bout[(size_t)tok * 512 + 128 * ps + cl] = (h16)o;
            }
          }
        }
      }
      SYNC();
    }

    if (PH(9)) for (int lj = xj.r; lj < 64 * 4; lj += xj.nrank) {
      int mt, nt; xjob_map(xj, lj, 512, 4, mt, nt); const int m0 = mt * 128;
      const int wrow = nt * 128;
      floatx16 acc[2][2]; acc_zero<2>(acc);
      gemm_core<2>(x16 + (size_t)m0 * 1024, 1024, Wt + WT_IN + (size_t)wrow * 1024, 1024, 1024, acc, As, Bs);
      epi_apply<2>(acc, [&](int r, int c, float v) { zpa[(size_t)(m0 + r) * 512 + nt * 128 + c] = (h16)v; });
    }
    SYNC();
    if (PH(10)) for (int idx = blockIdx.x * 256 + otid(); idx < NTOK * 64; idx += gthreads) {
      const int tok = idx >> 6, c0 = (idx & 63) * 8;
      int s0, len; seq_of(tok, s0, len);
      const int wd = 2 << (c0 >> 7);
      const int pos = tok - s0;
      const int lo = max(pos - wd / 2, 0), hi = min(pos + wd / 2 - 1, len - 1);
      float sum[8];
#pragma unroll
      for (int j = 0; j < 8; ++j) sum[j] = 0.f;
#pragma unroll
      for (int k = 0; k < 16; ++k) {
        const int tt = lo + k;
        const bool ok = tt <= hi;
        const half8 z = *(const half8*)&zpa[(size_t)(s0 + (ok ? tt : hi)) * 512 + c0];
#pragma unroll
        for (int j = 0; j < 8; ++j) sum[j] += ok ? (float)z[j] : 0.f;
      }
      const half8 zc = *(const half8*)&zpa[(size_t)tok * 512 + c0];
      const float ic = __builtin_amdgcn_rcpf((float)(hi - lo + 1));
      half8 o;
#pragma unroll
      for (int j = 0; j < 8; ++j) o[j] = (h16)(sum[j] * ic - (float)zc[j]);
      *(half8*)&pa[(size_t)tok * 512 + c0] = o;
    }
    if (PH(11)) for (int item = blockIdx.x; item < 4096; item += gridDim.x)
      attn_item(item, zatt, cout_, p.in[2], p.in[17] + (size_t)L * 8, (h16*)smem, (h16*)(smem + 18432), (float*)(smem + 18432 + 17408));
    SYNC();
    if (PH(12)) for (int lj = xj.r; lj < 64 * 4; lj += xj.nrank) {
      int mt, g; xjob_map(xj, lj, 512, 4, mt, g); const int m0 = mt * 128;
      floatx16 acc[2][2]; acc_zero<2>(acc);
      gemm_core<2>(pa + (size_t)m0 * 512 + 128 * g, 512, Wt + WT_POOL + (size_t)g * 128 * 128, 128, 128, acc, As, Bs);
      const float* psc = p.in[5] + (size_t)L * 512 + 128 * g;
      const int cc_ = ((otid() >> 6) & 1) * 64 + (otid() & 31);
      const float pscv[2] = {psc[cc_], psc[cc_ + 32]};
      epi_apply<2>(acc, [&](int r, int c, float v) { aout[(size_t)(m0 + r) * 512 + 128 * g + c] = (h16)(v * ((c >> 5) & 1 ? pscv[1] : pscv[0])); });
    }
    SYNC();
    if (PH(13)) for (int lj = xj.r; lj < 64 * 16; lj += xj.nrank) {
      int mt, nt; xjob_map(xj, lj, 512, 16, mt, nt); const int m0 = mt * 128, n0 = nt * 64;
      floatx16 mg[2][1]; acc_zero<1>(mg);
      for (int b = 0; b < 3; ++b) {
        floatx16 ag[2][1]; acc_zero<1>(ag);
        gemm_core<1>(x16 + (size_t)m0 * 1024, 1024, Wt + WT_IN + (size_t)(3200 + 1024 * b + n0) * 1024, 1024, 1024, ag, As, Bs);
        floatx16 ap[2][1]; acc_zero<1>(ap);
        const h16* br = b == 0 ? aout : (b == 1 ? bout : cout_);
        gemm_core<1>(br + (size_t)m0 * 512, 512, Wt + WT_BR + (size_t)(b * 1024 + n0) * 512, 512, 512, ap, As, Bs);
#pragma unroll
        for (int i = 0; i < 2; ++i)
#pragma unroll
          for (int r = 0; r < 16; ++r) mg[i][0][r] += sigmoidf_(ag[i][0][r]) * ap[i][0][r];
      }
      epi_apply<1>(mg, [&](int r, int c, float v) { merged[(size_t)(m0 + r) * 1024 + n0 + c] = (h16)v; });
    }
    SYNC();
    if (PH(14)) for (int lj = xj.r; lj < 64 * 8; lj += xj.nrank) {
      int mt, nt; xjob_map(xj, lj, 512, 8, mt, nt); const int m0 = mt * 128, n0 = nt * 128;
      floatx16 acc[2][2]; acc_init_resid<2>(acc, x16 + (size_t)m0 * 1024 + n0, 1024);
      gemm_core<2>(merged + (size_t)m0 * 1024, 1024, Wt + WT_O + (size_t)n0 * 1024, 1024, 1024, acc, As, Bs);
      epi_apply<2>(acc, [&](int r, int c, float v) { ypre1[(size_t)(m0 + r) * 1024 + n0 + c] = (h16)v; });
    }
    SYNC();
    if (PH(15)) ln_phase(ypre1, p.in[20] + (size_t)L * 1024, p.in[21] + (size_t)L * 1024, x16, nullptr, false, gw, nw);
    SYNC();
    for (int hf = 0; hf < 4; ++hf) {
      if (PH(16)) for (int lj = xj.r; lj < 16 * 32; lj += xj.nrank) {
        int mt, nt; xjob_map(xj, lj, 128, 32, mt, nt); const int m0 = mt * 128, n0 = nt * 128;
        floatx16 acc[2][2]; acc_zero<2>(acc);
        gemm_core<2>(x16 + (size_t)(hf * 16384 + m0) * 1024, 1024, Wt + WT_F1 + (size_t)n0 * 1024, 1024, 1024, acc, As, Bs);
        epi_apply<2>(acc, [&](int r, int c, float v) {
          const float u = fmaxf(v, 0.f);
          hid[(size_t)(m0 + r) * 4096 + n0 + c] = (h16)(u * u);
        });
      }
      SYNC();
      if (PH(17)) for (int lj = xj.r; lj < 16 * 8; lj += xj.nrank) {
        int mt, nt; xjob_map(xj, lj, 128, 8, mt, nt); const int m0 = mt * 128, n0 = nt * 128;
        floatx16 acc[2][2]; acc_init_resid<2>(acc, x16 + (size_t)(hf * 16384 + m0) * 1024 + n0, 1024);
        gemm_core<2>(hid + (size_t)m0 * 4096, 4096, Wt + WT_F2 + (size_t)n0 * 4096, 4096, 4096, acc, As, Bs);
        epi_apply<2>(acc, [&](int r, int c, float v) { ypre2[(size_t)(hf * 16384 + m0 + r) * 1024 + n0 + c] = (h16)v; });
      }
      SYNC();
    }
    if (PH(18)) ln_phase(ypre2, p.in[24] + (size_t)L * 1024, p.in[25] + (size_t)L * 1024, x16, p.out, L == 3, gw, nw);
    SYNC();
  }
}

extern "C" void kernel_launch(void* const* d_in, const int* in_sizes, int n_in, void* d_out, int out_size,
                              void* d_ws, size_t ws_size, hipStream_t stream) {
  static int grid_blocks = 0;
  if (!grid_blocks) {
    int dev = 0, cus = 0, per_cu = 0;
    hipGetDevice(&dev);
    hipDeviceGetAttribute(&cus, hipDeviceAttributeMultiprocessorCount, dev);
    hipOccupancyMaxActiveBlocksPerMultiprocessor(&per_cu, mega, 256, 0);
    if (per_cu > 2) per_cu = 2;
    if (per_cu < 1) per_cu = 1;
    grid_blocks = cus * per_cu;
  }
  Params p{};
  for (int i = 0; i < 26; ++i) p.in[i] = (const float*)d_in[i];
  p.out = (float*)d_out;
  p.ws = (char*)d_ws;
  hipMemsetAsync((char*)d_ws + W_BAR, 0, XCD_BAR_WORDS * sizeof(unsigned), stream);
  void* args[] = {&p};
  hipError_t e = hipLaunchCooperativeKernel((void*)mega, dim3(grid_blocks), dim3(256), args, 0, stream);
  if (e != hipSuccess) fprintf(stderr, "cooperative launch failed: %s (grid %d)\n", hipGetErrorString(e), grid_blocks);
}
```
